# Optimizing an MI355X kernel written in HIP

```python
import jax, jax.numpy as jnp
from jax import lax
import numpy as np

D_MODEL = 1024
BATCH = 4
SEQ = 8192
DEPTH = 2
DEC_BATCH = 2
DEC_SEQ = 16384
PAST_LEN = 128

A_PATTERNS = ((128, 1), (512, 4), (2048, 16))
A_GROUPS = 3
A_HEADS = 8
A_HD = 64
A_W = A_GROUPS * A_HEADS * A_HD
A_OUT = A_HEADS * A_HD
B_HEADS = 4
B_DK = 64
B_DV = 128
B_CHUNK = 128
B_QK = B_HEADS * B_DK
B_OUT = B_HEADS * B_DV
C_HEADS = 8
C_HD = 64
C_W = C_HEADS * C_HD
GRID_W = 64
C_KH_MAX = 8
C_KW = 16
C_QR = 2
C_QC = 16
C_KC = 32
N_BRANCH = 3
D_FF = 2816
LN_EPS = 1e-5
GN_EPS = 1e-5
ALPHA = (2 * DEPTH) ** 0.25
BETA = (8 * DEPTH) ** -0.25
IN_SPLITS = (A_W, A_W, A_W, B_QK, B_QK, B_OUT, B_OUT, C_W, C_W, C_W, N_BRANCH * D_MODEL)
D_IN = sum(IN_SPLITS)

kernel_name = 'hybrid_bidir_encoder_dilated_retention_natten'


def layer_norm(x, g, b):
    xf = x.astype(jnp.float32)
    mu = xf.mean(-1, keepdims=True)
    var = jnp.square(xf - mu).mean(-1, keepdims=True)
    y = (xf - mu) * lax.rsqrt(var + LN_EPS)
    return (y * g.astype(jnp.float32) + b.astype(jnp.float32)).astype(x.dtype)


def swiglu(x, w_gate, w_up, w_down):
    return (jax.nn.silu(x @ w_gate) * (x @ w_up)) @ w_down


def alibi_slopes(n):
    return 2.0 ** (-8.0 * jnp.arange(1, n + 1, dtype=jnp.float32) / n)


def split_columns(z):
    outs, start = [], 0
    for w in IN_SPLITS:
        outs.append(z[..., start:start + w])
        start += w
    return outs


def dilated_window_attention(q, k, v, dilation, half, slopes):
    b, s, h, hd = q.shape
    L = s // dilation
    nb = -(-L // half)
    Lp = nb * half

    def by_residue(t):
        return t.reshape(b, L, dilation, h, hd).transpose(0, 2, 3, 1, 4)

    qd, kd, vd = by_residue(q), by_residue(k), by_residue(v)
    qb = jnp.pad(qd, ((0, 0),) * 3 + ((0, Lp - L), (0, 0))).reshape(b, dilation, h, nb, half, hd)

    def key_blocks(t):
        tp = jnp.pad(t, ((0, 0),) * 3 + ((half, Lp - L + half), (0, 0))).reshape(b, dilation, h, nb + 2, half, hd)
        return jnp.concatenate([tp[:, :, :, :-2], tp[:, :, :, 1:-1], tp[:, :, :, 2:]], axis=4)

    kb, vb = key_blocks(kd), key_blocks(vd)
    qi = jnp.arange(nb)[:, None] * half + jnp.arange(half)[None, :]
    kj = (jnp.arange(nb)[:, None] - 1) * half + jnp.arange(3 * half)[None, :]
    rel = kj[:, None, :] - qi[:, :, None]
    valid = (jnp.abs(rel) <= half) & (kj[:, None, :] >= 0) & (kj[:, None, :] < L)
    dist = (jnp.abs(rel) * dilation).astype(jnp.float32)
    bias = -slopes[:, None, None, None] * dist
    scores = jnp.einsum('bdhnqe,bdhnke->bdhnqk', qb, kb, preferred_element_type=jnp.float32) * (hd ** -0.5) + bias
    scores = jnp.where(valid, scores, -jnp.inf)
    lse = jax.nn.logsumexp(scores, axis=-1)
    p = jnp.exp(scores - lse[..., None])
    out = jnp.einsum('bdhnqk,bdhnke->bdhnqe', p.astype(v.dtype), vb)
    out = out.reshape(b, dilation, h, Lp, hd)[:, :, :, :L].transpose(0, 3, 1, 2, 4).reshape(b, s, h, hd)
    lse = lse.reshape(b, dilation, h, Lp)[..., :L].transpose(0, 3, 1, 2).reshape(b, s, h)
    return out, lse


def mixer_a(qa, ka, va):
    b, s, _ = qa.shape
    shp = (b, s, A_GROUPS, A_HEADS, A_HD)
    qa, ka, va = qa.reshape(shp), ka.reshape(shp), va.reshape(shp)
    slopes = alibi_slopes(A_HEADS)
    outs, lses = [], []
    for g, (window, dil) in enumerate(A_PATTERNS):
        o, l = dilated_window_attention(qa[:, :, g], ka[:, :, g], va[:, :, g], dil, window // (2 * dil), slopes)
        outs.append(o.astype(jnp.float32))
        lses.append(l)
    w = jax.nn.softmax(jnp.stack(lses, 0), axis=0)
    o = jnp.einsum('gbsh,gbshe->bshe', w, jnp.stack(outs, 0))
    return o.reshape(b, s, A_OUT).astype(qa.dtype)


def retention_chunkwise(q, k, v, log_gamma, include_diag):
    c = q.shape[3]
    idx = jnp.arange(c, dtype=jnp.float32)
    diff = idx[:, None] - idx[None, :]
    mask = diff >= 0 if include_diag else diff > 0
    decay = jnp.where(mask, jnp.exp(log_gamma[:, None, None] * jnp.where(mask, diff, 0.0)), 0.0)
    inner = jnp.einsum('bhnid,bhnjd->bhnij', q, k) * decay[:, None]
    inner = jnp.einsum('bhnij,bhnje->bhnie', inner, v)
    k_decay = jnp.exp(log_gamma[:, None] * (c - 1 - idx))
    q_decay = jnp.exp(log_gamma[:, None] * (idx + 1))
    chunk_kv = jnp.einsum('bhnjd,bhnje->nbhde', k * k_decay[:, None, :, None], v)
    chunk_decay = jnp.exp(log_gamma * c)[:, None, None]

    def step(state, kv):
        return chunk_decay * state + kv, state

    _, prev = lax.scan(step, jnp.zeros_like(chunk_kv[0]), chunk_kv)
    cross = jnp.einsum('bhnid,nbhde->bhnie', q * q_decay[:, None, :, None], prev)
    return inner + cross


def mixer_b(qb, kb, vb, gb, logit_fwd, logit_bwd):
    b, s, _ = qb.shape
    n = s // B_CHUNK

    def heads(t, dh):
        return t.astype(jnp.float32).reshape(b, n, B_CHUNK, B_HEADS, dh).transpose(0, 3, 1, 2, 4)

    def flip(t):
        return t[:, :, ::-1, ::-1]

    q = heads(qb, B_DK)
    k = heads(kb, B_DK) * (B_DK ** -0.5)
    v = heads(vb, B_DV)
    lg_f = jax.nn.log_sigmoid(logit_fwd.astype(jnp.float32))
    lg_b = jax.nn.log_sigmoid(logit_bwd.astype(jnp.float32))
    y = retention_chunkwise(q, k, v, lg_f, True) + flip(retention_chunkwise(flip(q), flip(k), flip(v), lg_b, False))
    mu = y.mean(-1, keepdims=True)
    var = jnp.square(y - mu).mean(-1, keepdims=True)
    y = (y - mu) * lax.rsqrt(var + GN_EPS)
    y = y.transpose(0, 2, 3, 1, 4).reshape(b, s, B_OUT)
    return (jax.nn.silu(gb.astype(jnp.float32)) * y).astype(qb.dtype)


def mixer_c(qc, kc, vc, rpb):
    b, s, _ = qc.shape
    rows = s // GRID_W
    kh = min(C_KH_MAX, rows)
    rr = min(kh + 1, rows)
    nrb = rows // C_QR
    ncb = GRID_W // C_QC

    def grid(t):
        return t.reshape(b, rows, GRID_W, C_HEADS, C_HD).transpose(0, 3, 1, 2, 4)

    qg, kg, vg = grid(qc), grid(kc), grid(vc)
    row_start = jnp.clip(jnp.arange(rows) - kh // 2, 0, rows - kh)
    col_start = jnp.clip(jnp.arange(GRID_W) - C_KW // 2, 0, GRID_W - C_KW)
    rb_start = jnp.clip(row_start[::C_QR], 0, rows - rr)
    cb_start = jnp.clip(jnp.arange(ncb) * C_QC - C_KW // 2, 0, GRID_W - C_KC)
    key_rows = rb_start[:, None] + jnp.arange(rr)[None, :]
    key_cols = cb_start[:, None] + jnp.arange(C_KC)[None, :]
    ri = key_rows[:, :, None, None]
    ci = key_cols[None, None, :, :]
    kr = kg[:, :, ri, ci]
    vr = vg[:, :, ri, ci]
    qr = qg.reshape(b, C_HEADS, nrb, C_QR, ncb, C_QC, C_HD)
    scores = jnp.einsum('bhnqcwe,bhnrcke->bhnqcwrk', qr, kr, preferred_element_type=jnp.float32) * (C_HD ** -0.5)

    qrow = jnp.arange(nrb)[:, None] * C_QR + jnp.arange(C_QR)[None, :]
    qcol = jnp.arange(ncb)[:, None] * C_QC + jnp.arange(C_QC)[None, :]
    rs = row_start[qrow][..., None]
    cs = col_start[qcol][..., None]
    kr_idx = key_rows[:, None, :]
    kc_idx = key_cols[:, None, :]
    row_ok = (kr_idx >= rs) & (kr_idx < rs + kh)
    col_ok = (kc_idx >= cs) & (kc_idx < cs + C_KW)
    mask = row_ok[:, :, None, None, :, None] & col_ok[None, None, :, :, None, :]
    dr = jnp.clip(kr_idx - qrow[..., None], -(C_KH_MAX - 1), C_KH_MAX - 1) + (C_KH_MAX - 1)
    dc = jnp.clip(kc_idx - qcol[..., None], -(C_KW - 1), C_KW - 1) + (C_KW - 1)
    bias = rpb.astype(jnp.float32)[:, dr[:, :, None, None, :, None], dc[None, None, :, :, None, :]]
    scores = jnp.where(mask, scores + bias, -jnp.inf)
    p = jax.nn.softmax(scores, axis=(-2, -1))
    out = jnp.einsum('bhnqcwrk,bhnrcke->bhnqcwe', p.astype(vr.dtype), vr)
    out = out.reshape(b, C_HEADS, rows, GRID_W, C_HD).transpose(0, 2, 3, 1, 4).reshape(b, s, C_W)
    return out.astype(qc.dtype)


def encoder_layer(x, ffn1_w_gate, ffn1_w_up, ffn1_w_down, ln1_g, ln1_b, w_in, ret_logit_fwd, ret_logit_bwd,
                  na_rpb, w_branch_a, w_branch_b, w_branch_c, w_out, ln2_g, ln2_b,
                  ffn2_w_gate, ffn2_w_up, ffn2_w_down, ln3_g, ln3_b):
    b, s, _ = x.shape
    x = layer_norm(ALPHA * x + 0.5 * swiglu(x, ffn1_w_gate, ffn1_w_up, ffn1_w_down), ln1_g, ln1_b)
    z = x @ w_in
    aq, ak, av, bq, bk, bv, bg, cq, ck, cv, gates = split_columns(z)
    ya = mixer_a(aq, ak, av)
    yb = mixer_b(bq, bk, bv, bg, ret_logit_fwd, ret_logit_bwd)
    yc = mixer_c(cq, ck, cv, na_rpb)
    g = jax.nn.sigmoid(gates).reshape(b, s, N_BRANCH, D_MODEL)
    merged = g[:, :, 0] * (ya @ w_branch_a) + g[:, :, 1] * (yb @ w_branch_b) + g[:, :, 2] * (yc @ w_branch_c)
    x = layer_norm(ALPHA * x + merged @ w_out, ln2_g, ln2_b)
    x = layer_norm(ALPHA * x + 0.5 * swiglu(x, ffn2_w_gate, ffn2_w_up, ffn2_w_down), ln3_g, ln3_b)
    return x


def run_trunk(x, ffn1_w_gate, ffn1_w_up, ffn1_w_down, ln1_g, ln1_b, w_in, ret_logit_fwd, ret_logit_bwd,
              na_rpb, w_branch_a, w_branch_b, w_branch_c, w_out, ln2_g, ln2_b,
              ffn2_w_gate, ffn2_w_up, ffn2_w_down, ln3_g, ln3_b):
    for i in range(DEPTH):
        x = encoder_layer(x, ffn1_w_gate[i], ffn1_w_up[i], ffn1_w_down[i], ln1_g[i], ln1_b[i], w_in[i],
                          ret_logit_fwd[i], ret_logit_bwd[i], na_rpb[i], w_branch_a[i], w_branch_b[i],
                          w_branch_c[i], w_out[i], ln2_g[i], ln2_b[i], ffn2_w_gate[i], ffn2_w_up[i],
                          ffn2_w_down[i], ln3_g[i], ln3_b[i])
    return x


def setup_inputs(seed: int = 0) -> dict:
    key = jax.random.key(seed)
    ks = jax.random.split(key, 22)
    f32 = jnp.float32

    def nrm(k, shape, scale):
        return jax.random.normal(k, shape, f32) * scale

    levels = jnp.arange(5, 5 + B_HEADS, dtype=f32)
    base_logit = jnp.log(2.0 ** levels - 1.0)
    return {
        'x_prompt': nrm(ks[0], (BATCH, SEQ, D_MODEL), 1.0),
        'x_sample': nrm(ks[1], (DEC_BATCH, DEC_SEQ, D_MODEL), 1.0),
        'ffn1_w_gate': nrm(ks[2], (DEPTH, D_MODEL, D_FF), D_MODEL ** -0.5),
        'ffn1_w_up': nrm(ks[3], (DEPTH, D_MODEL, D_FF), D_MODEL ** -0.5),
        'ffn1_w_down': nrm(ks[4], (DEPTH, D_FF, D_MODEL), BETA * D_FF ** -0.5),
        'ln1_g': 1.0 + nrm(ks[5], (DEPTH, D_MODEL), 0.02),
        'ln1_b': nrm(ks[6], (DEPTH, D_MODEL), 0.02),
        'w_in': nrm(ks[7], (DEPTH, D_MODEL, D_IN), D_MODEL ** -0.5),
        'ret_logit_fwd': base_logit + nrm(ks[8], (DEPTH, B_HEADS), 0.1),
        'ret_logit_bwd': base_logit + nrm(ks[9], (DEPTH, B_HEADS), 0.1),
        'na_rpb': nrm(ks[10], (DEPTH, C_HEADS, 2 * C_KH_MAX - 1, 2 * C_KW - 1), 0.02),
        'w_branch_a': nrm(ks[11], (DEPTH, A_OUT, D_MODEL), A_OUT ** -0.5),
        'w_branch_b': nrm(ks[12], (DEPTH, B_OUT, D_MODEL), B_OUT ** -0.5),
        'w_branch_c': nrm(ks[13], (DEPTH, C_W, D_MODEL), C_W ** -0.5),
        'w_out': nrm(ks[14], (DEPTH, D_MODEL, D_MODEL), BETA * D_MODEL ** -0.5),
        'ln2_g': 1.0 + nrm(ks[15], (DEPTH, D_MODEL), 0.02),
        'ln2_b': nrm(ks[16], (DEPTH, D_MODEL), 0.02),
        'ffn2_w_gate': nrm(ks[17], (DEPTH, D_MODEL, D_FF), D_MODEL ** -0.5),
        'ffn2_w_up': nrm(ks[18], (DEPTH, D_MODEL, D_FF), D_MODEL ** -0.5),
        'ffn2_w_down': nrm(ks[19], (DEPTH, D_FF, D_MODEL), BETA * D_FF ** -0.5),
        'ln3_g': 1.0 + nrm(ks[20], (DEPTH, D_MODEL), 0.02),
        'ln3_b': nrm(ks[21], (DEPTH, D_MODEL), 0.02),
    }


def reference(x_prompt, x_sample, ffn1_w_gate, ffn1_w_up, ffn1_w_down, ln1_g, ln1_b, w_in, ret_logit_fwd,
              ret_logit_bwd, na_rpb, w_branch_a, w_branch_b, w_branch_c, w_out, ln2_g, ln2_b,
              ffn2_w_gate, ffn2_w_up, ffn2_w_down, ln3_g, ln3_b):
    y_prompt = run_trunk(x_prompt, ffn1_w_gate, ffn1_w_up, ffn1_w_down, ln1_g, ln1_b, w_in, ret_logit_fwd,
                         ret_logit_bwd, na_rpb, w_branch_a, w_branch_b, w_branch_c, w_out, ln2_g, ln2_b,
                         ffn2_w_gate, ffn2_w_up, ffn2_w_down, ln3_g, ln3_b)
    y_sample = run_trunk(x_sample, ffn1_w_gate, ffn1_w_up, ffn1_w_down, ln1_g, ln1_b, w_in, ret_logit_fwd,
                         ret_logit_bwd, na_rpb, w_branch_a, w_branch_b, w_branch_c, w_out, ln2_g, ln2_b,
                         ffn2_w_gate, ffn2_w_up, ffn2_w_down, ln3_g, ln3_b)
    return (y_prompt, y_sample)
```

```cpp
#include <hip/hip_runtime.h>
#include <hip/hip_cooperative_groups.h>
#include <cstdio>
#include <cstdint>
namespace cg = cooperative_groups;

namespace pg8 {
#define PG8_LAS __attribute__((address_space(3)))
typedef unsigned short bf16_t;
typedef short bf16x8 __attribute__((ext_vector_type(8)));
typedef float f32x4 __attribute__((ext_vector_type(4)));
typedef unsigned u32x4 __attribute__((ext_vector_type(4)));
constexpr int BM = 256, BK = 64, HALF = 128, HTB = HALF * BK * 2, STAGE_BYTES = 8 * HTB, NXCD = 8, WGM = 8;

__host__ __device__ __forceinline__ int lds_byte(int r, int c) { const int st = (r >> 4) * 2 + (c >> 5), rr = r & 15, cc = c & 31, ob = rr * 64 + cc * 2; return st * 1024 + (ob ^ (((ob >> 9) & 1) << 5)); }
__host__ __device__ __forceinline__ void stage_rc(int b, int& R, int& C) { const int st = b / 1024, sb = b % 1024, swz = sb ^ (((sb >> 9) & 1) << 5); R = (st >> 1) * 16 + swz / 64; C = (st & 1) * 32 + (swz % 64) / 2; }
__host__ __device__ __forceinline__ int perm32(int rho) { const int n = rho >> 4, i = rho & 15; return 8 * (i >> 2) + 4 * n + (i & 3); }

struct Unit { int pm, pn; };
struct Gemm { const bf16_t* A; const bf16_t* Bt; int M, N, K; };

struct StaticOrder {
    int nM, nN, nwg, G, c;
    __host__ __device__ void init(int M, int N, int G_, int c_) { nM = M / BM; nN = N / BM; nwg = nM * nN; G = G_; c = c_; }
    __host__ __device__ bool next(int i, Unit& u) const {
        const long L = (long)i * G + c; if (L >= nwg) return false;
        int wgid = (int)L; { const int q = nwg / NXCD, r = nwg % NXCD, xcd = wgid % NXCD, off = wgid / NXCD; wgid = (xcd < r ? xcd * (q + 1) : r * (q + 1) + (xcd - r) * q) + off; }
        const int nig = WGM * nN, gid = wgid / nig, fm = gid * WGM, gsz = (nM - fm) < WGM ? (nM - fm) : WGM;
        u.pm = fm + ((wgid % nig) % gsz); u.pn = (wgid % nig) / gsz; return true;
    }
};
struct Sched {
    StaticOrder S0; int nbr, nMt, nNt;
    __device__ void init(int M, int N, int nbr_, int G_, int c_) { S0.init(M, N, G_, c_); nbr = nbr_; nMt = M / BM; nNt = N / BM; }
    __device__ bool next(int i, Unit& u) const {
        if (nbr == 1) return S0.next(i, u);
        Unit t; if (!S0.next(i / 3, t)) return false; const int b = i % 3; u.pm = b * nMt + t.pm; u.pn = b * nNt + t.pn; return true; }
    __device__ bool carry(int i) const { return nbr == 3 && (i % 3) != 2; }
};

__device__ __forceinline__ unsigned cvt_pk_bf16(float lo, float hi) { unsigned r; asm volatile("v_cvt_pk_bf16_f32 %0, %1, %2" : "=v"(r) : "v"(lo), "v"(hi)); return r; }
__device__ __forceinline__ float bflo(unsigned w) { return __uint_as_float(w << 16); }
__device__ __forceinline__ float bfhi(unsigned w) { return __uint_as_float(w & 0xffff0000u); }
__device__ __forceinline__ float sigmoidf_(float x) { return __builtin_amdgcn_rcpf(1.f + __expf(-x)); }

struct EpiSwiglu {
    static constexpr bool PERM = true;
    bf16_t* H; int ldh;
    __device__ __forceinline__ void operator()(const f32x4 (&acc)[2][2][4][2], const Unit& u, int wr, int wc, int fr, int fq) const {
        const int row0 = u.pm * BM + wr * 64 + fr, col0 = u.pn * HALF + wc * 32 + 8 * fq;
#pragma unroll
        for (int ai = 0; ai < 2; ++ai)
#pragma unroll
            for (int m = 0; m < 4; ++m) {
                f32x4 hv[2];
#pragma unroll
                for (int n = 0; n < 2; ++n) {
                    const f32x4 g = acc[ai][0][m][n], up = acc[ai][1][m][n];
                    const f32x4 t = g * (-1.44269504088896341f);
                    f32x4 d; d[0] = __builtin_amdgcn_exp2f(t[0]); d[1] = __builtin_amdgcn_exp2f(t[1]); d[2] = __builtin_amdgcn_exp2f(t[2]); d[3] = __builtin_amdgcn_exp2f(t[3]);
                    d = d + 1.0f;
                    f32x4 r; r[0] = __builtin_amdgcn_rcpf(d[0]); r[1] = __builtin_amdgcn_rcpf(d[1]); r[2] = __builtin_amdgcn_rcpf(d[2]); r[3] = __builtin_amdgcn_rcpf(d[3]);
                    hv[n] = (g * up) * r;
                }
                u32x4 w; w.x = cvt_pk_bf16(hv[0][0], hv[0][1]); w.y = cvt_pk_bf16(hv[0][2], hv[0][3]); w.z = cvt_pk_bf16(hv[1][0], hv[1][1]); w.w = cvt_pk_bf16(hv[1][2], hv[1][3]);
                *(u32x4*)(H + (size_t)(row0 + ai * HALF + m * 16) * ldh + col0) = w;
            }
    }
};
struct EpiResid {
    static constexpr bool PERM = true;
    const float* Xin; float* Xout; bf16_t* XB; float* EX; const float* gam; const float* bet; unsigned* cnt; unsigned target; int pbase; float alpha, s;
    __device__ __forceinline__ void operator()(f32x4 (&acc)[2][2][4][2], const Unit& u, int wr, int wc, int fr, int fq, PG8_LAS float* sl) const {
        const int tid = threadIdx.x;
        const int lr0 = wr * 64 + fr, col0 = u.pn * BM + wc * 32 + 8 * fq;
        PG8_LAS float* red = sl + 1008;
#pragma unroll
        for (int ai = 0; ai < 2; ++ai) {
            f32x4 xl[4][2][2];
#pragma unroll
            for (int m = 0; m < 4; ++m)
#pragma unroll
                for (int bj = 0; bj < 2; ++bj) {
                    const size_t off = (size_t)(u.pm * BM + lr0 + ai * HALF + m * 16) * 1024 + col0 + bj * HALF;
                    xl[m][bj][0] = *(const f32x4*)(Xin + off); xl[m][bj][1] = *(const f32x4*)(Xin + off + 4);
                }
#pragma unroll
            for (int m = 0; m < 4; ++m) {
                const int lr = lr0 + ai * HALF + m * 16;
                float rs = 0.f, rq = 0.f;
#pragma unroll
                for (int bj = 0; bj < 2; ++bj) {
                    const f32x4 x0 = xl[m][bj][0] * alpha + acc[ai][bj][m][0] * s, x1 = xl[m][bj][1] * alpha + acc[ai][bj][m][1] * s;
                    acc[ai][bj][m][0] = x0; acc[ai][bj][m][1] = x1;
                    rs += (x0[0] + x0[1]) + (x0[2] + x0[3]) + (x1[0] + x1[1]) + (x1[2] + x1[3]);
                    rq += (x0[0] * x0[0] + x0[1] * x0[1]) + (x0[2] * x0[2] + x0[3] * x0[3]) + (x1[0] * x1[0] + x1[1] * x1[1]) + (x1[2] * x1[2] + x1[3] * x1[3]);
                }
                rs += __shfl_xor(rs, 16); rs += __shfl_xor(rs, 32); rq += __shfl_xor(rq, 16); rq += __shfl_xor(rq, 32);
                if (fq == 0) { red[(wc * 256 + lr) * 2] = rs; red[(wc * 256 + lr) * 2 + 1] = rq; }
            }
            __builtin_amdgcn_sched_barrier(0);
        }
        asm volatile("s_waitcnt lgkmcnt(0)" ::: "memory"); __builtin_amdgcn_s_barrier();
        const int panel = pbase + u.pm;
        if (tid < 256) {
            float a = 0.f, b = 0.f;
#pragma unroll
            for (int k = 0; k < 4; ++k) { a += red[(k * 256 + tid) * 2]; b += red[(k * 256 + tid) * 2 + 1]; }
            float* ex = EX + ((size_t)(panel * 4 + u.pn) * 256 + tid) * 2;
            __hip_atomic_store(ex, a, __ATOMIC_RELAXED, __HIP_MEMORY_SCOPE_AGENT); __hip_atomic_store(ex + 1, b, __ATOMIC_RELAXED, __HIP_MEMORY_SCOPE_AGENT);
        }
        asm volatile("s_waitcnt vmcnt(0)" ::: "memory"); __builtin_amdgcn_s_barrier();
        if (tid == 0) {
            __hip_atomic_fetch_add(cnt + panel, 1u, __ATOMIC_RELAXED, __HIP_MEMORY_SCOPE_AGENT);
            unsigned sp = 0;
            while (__hip_atomic_load(cnt + panel, __ATOMIC_RELAXED, __HIP_MEMORY_SCOPE_AGENT) < target) { __builtin_amdgcn_s_sleep(1); if (++sp > (1u << 22)) break; }
        }
        __builtin_amdgcn_s_barrier();
        if (tid < 256) {
            float a = 0.f, b = 0.f;
#pragma unroll
            for (int k = 0; k < 4; ++k) { const float* ex = EX + ((size_t)(panel * 4 + k) * 256 + tid) * 2;
                a += __hip_atomic_load(ex, __ATOMIC_RELAXED, __HIP_MEMORY_SCOPE_AGENT); b += __hip_atomic_load(ex + 1, __ATOMIC_RELAXED, __HIP_MEMORY_SCOPE_AGENT); }
            const float mu = a * (1.f / 1024.f), var = fmaxf(b * (1.f / 1024.f) - mu * mu, 0.f);
            sl[2 * tid] = mu; sl[2 * tid + 1] = 1.f / sqrtf(var + 1e-5f);
        }
        asm volatile("s_waitcnt lgkmcnt(0)" ::: "memory"); __builtin_amdgcn_s_barrier();
#pragma unroll
        for (int bj = 0; bj < 2; ++bj) {
            const int col = col0 + bj * HALF;
            const f32x4 g0 = *(const f32x4*)(gam + col), g1 = *(const f32x4*)(gam + col + 4), b0 = *(const f32x4*)(bet + col), b1 = *(const f32x4*)(bet + col + 4);
#pragma unroll
            for (int ai = 0; ai < 2; ++ai)
#pragma unroll
                for (int m = 0; m < 4; ++m) {
                    const int lr = lr0 + ai * HALF + m * 16; const float mu = sl[2 * lr], rstd = sl[2 * lr + 1];
                    const size_t off = (size_t)(u.pm * BM + lr) * 1024 + col;
                    const f32x4 y0 = (acc[ai][bj][m][0] - mu) * rstd * g0 + b0, y1 = (acc[ai][bj][m][1] - mu) * rstd * g1 + b1;
                    *(f32x4*)(Xout + off) = y0; *(f32x4*)(Xout + off + 4) = y1;
                    u32x4 w; w.x = cvt_pk_bf16(y0[0], y0[1]); w.y = cvt_pk_bf16(y0[2], y0[3]); w.z = cvt_pk_bf16(y1[0], y1[1]); w.w = cvt_pk_bf16(y1[2], y1[3]);
                    *(u32x4*)(XB + off) = w;
                    __builtin_amdgcn_sched_barrier(0);
                }
        }
    }
};
struct EpiWin {
    static constexpr bool PERM = true;
    bf16_t* Z; bf16_t* Gt;
    __device__ __forceinline__ void operator()(const f32x4 (&acc)[2][2][4][2], const Unit& u, int wr, int wc, int fr, int fq) const {
        const int row0 = u.pm * BM + wr * 64 + fr; const bool isg = u.pn >= 30;
        bf16_t* base = isg ? Gt : Z; const int ld = isg ? 3072 : 7680; const int col0 = (isg ? (u.pn - 30) : u.pn) * BM + wc * 32 + 8 * fq;
#pragma unroll
        for (int ai = 0; ai < 2; ++ai)
#pragma unroll
            for (int m = 0; m < 4; ++m)
#pragma unroll
                for (int bj = 0; bj < 2; ++bj) {
                    f32x4 v0 = acc[ai][bj][m][0], v1 = acc[ai][bj][m][1];
                    if (isg) {
#pragma unroll
                        for (int j = 0; j < 4; ++j) { v0[j] = 1.f + __builtin_amdgcn_exp2f(v0[j] * -1.44269504088896341f); v1[j] = 1.f + __builtin_amdgcn_exp2f(v1[j] * -1.44269504088896341f); }
                    }
                    u32x4 w; w.x = cvt_pk_bf16(v0[0], v0[1]); w.y = cvt_pk_bf16(v0[2], v0[3]); w.z = cvt_pk_bf16(v1[0], v1[1]); w.w = cvt_pk_bf16(v1[2], v1[3]);
                    *(u32x4*)(base + (size_t)(row0 + ai * HALF + m * 16) * ld + col0 + bj * HALF) = w;
                }
    }
};
struct EpiBranch {
    static constexpr bool PERM = true;
    const bf16_t* Gt; bf16_t* Mg; int nMt;
    __device__ __forceinline__ void operator()(f32x4 (&acc)[2][2][4][2], const Unit& u, int wr, int wc, int fr, int fq) const {
        const int b = u.pm / nMt, pm = u.pm - b * nMt, pn = u.pn - b * 4;
        const int row0 = pm * BM + wr * 64 + fr, col0 = pn * BM + wc * 32 + 8 * fq;
#pragma unroll
        for (int ai = 0; ai < 2; ++ai) {
            u32x4 gw[4][2], gn[4][2];
#pragma unroll
            for (int m = 0; m < 4; ++m)
#pragma unroll
                for (int bj = 0; bj < 2; ++bj) {
                    const size_t row = (size_t)(row0 + ai * HALF + m * 16); const int col = col0 + bj * HALF;
                    gw[m][bj] = *(const u32x4*)(Gt + row * 3072 + b * 1024 + col);
                    if (b < 2) gn[m][bj] = *(const u32x4*)(Gt + row * 3072 + (b + 1) * 1024 + col); else gn[m][bj] = gw[m][bj];
                }
#pragma unroll
            for (int m = 0; m < 4; ++m)
#pragma unroll
                for (int bj = 0; bj < 2; ++bj) {
                    const u32x4 g = gw[m][bj], h = gn[m][bj];
                    f32x4 g0 = {bflo(g.x), bfhi(g.x), bflo(g.y), bfhi(g.y)}, g1 = {bflo(g.z), bfhi(g.z), bflo(g.w), bfhi(g.w)};
                    if (b < 2) {
                        const f32x4 h0 = {bflo(h.x), bfhi(h.x), bflo(h.y), bfhi(h.y)}, h1 = {bflo(h.z), bfhi(h.z), bflo(h.w), bfhi(h.w)};
#pragma unroll
                        for (int j = 0; j < 4; ++j) { g0[j] = h0[j] * __builtin_amdgcn_rcpf(g0[j]); g1[j] = h1[j] * __builtin_amdgcn_rcpf(g1[j]); }
                        acc[ai][bj][m][0] = acc[ai][bj][m][0] * g0; acc[ai][bj][m][1] = acc[ai][bj][m][1] * g1;
                    } else {
                        const size_t row = (size_t)(row0 + ai * HALF + m * 16); const int col = col0 + bj * HALF;
#pragma unroll
                        for (int j = 0; j < 4; ++j) { g0[j] = __builtin_amdgcn_rcpf(g0[j]); g1[j] = __builtin_amdgcn_rcpf(g1[j]); }
                        const f32x4 v0 = acc[ai][bj][m][0] * g0, v1 = acc[ai][bj][m][1] * g1;
                        u32x4 w; w.x = cvt_pk_bf16(v0[0], v0[1]); w.y = cvt_pk_bf16(v0[2], v0[3]); w.z = cvt_pk_bf16(v1[0], v1[1]); w.w = cvt_pk_bf16(v1[2], v1[3]);
                        *(u32x4*)(Mg + row * 1024 + col) = w;
                    }
                }
            __builtin_amdgcn_sched_barrier(0);
        }
    }
};

__device__ __forceinline__ unsigned long long ldsu64(PG8_LAS const unsigned long long* p) {
    const unsigned long long v = *p; const unsigned lo = __builtin_amdgcn_readfirstlane((unsigned)v), hi = __builtin_amdgcn_readfirstlane((unsigned)(v >> 32));
    return ((unsigned long long)hi << 32) | lo;
}
template <int KIND  > struct EpiAll {
    static constexpr bool PERM = true;
    __device__ __forceinline__ void operator()(f32x4 (&acc)[2][2][4][2], const Unit& u, int wr, int wc, int fr, int fq, PG8_LAS float* sl) const {
        asm volatile("" : "+v"(fr), "+v"(fq), "+s"(wr), "+s"(wc));
        PG8_LAS const unsigned long long* ep = (PG8_LAS const unsigned long long*)((PG8_LAS unsigned char*)sl + 2240);
        if constexpr (KIND == 1) { const unsigned long long as = ldsu64(ep + 8), tp = ldsu64(ep + 9);
            EpiResid e{(const float*)ldsu64(ep + 1), (float*)ldsu64(ep + 2), (bf16_t*)ldsu64(ep + 3), (float*)ldsu64(ep + 4), (const float*)ldsu64(ep + 5), (const float*)ldsu64(ep + 6),
                       (unsigned*)ldsu64(ep + 7), (unsigned)tp, (int)(unsigned)(tp >> 32), __uint_as_float((unsigned)as), __uint_as_float((unsigned)(as >> 32))}; e(acc, u, wr, wc, fr, fq, sl); }
        else if constexpr (KIND == 2) { EpiBranch e{(const bf16_t*)ldsu64(ep + 1), (bf16_t*)ldsu64(ep + 3), 64}; e(acc, u, wr, wc, fr, fq); }
        else {
            const unsigned long long s0 = ldsu64(ep); const int mode = (int)(unsigned)s0;
            if (mode == 0) { EpiSwiglu e{(bf16_t*)ldsu64(ep + 1), 2816}; e(acc, u, wr, wc, fr, fq); }
            else { EpiWin e{(bf16_t*)ldsu64(ep + 1), (bf16_t*)ldsu64(ep + 2)}; e(acc, u, wr, wc, fr, fq); }
        }
    }
};

template <class Epi, class Sched>
__device__ __forceinline__ void gemm_phase(PG8_LAS unsigned char* lds, const Gemm g, const Sched& S, const Epi& E) {
    int tid = threadIdx.x; asm volatile("" : "+v"(tid));
    const int wid = __builtin_amdgcn_readfirstlane(tid >> 6), lane = tid & 63, wr = wid >> 2, wc = wid & 3, fr = lane & 15, fq = lane >> 4;
    const int K = g.K, nt = K / BK;
    unsigned voffA[2], voffB[2];
#pragma unroll
    for (int i = 0; i < 2; ++i) { int R, C; stage_rc(tid * 16 + i * 8192, R, C); const int Rb = Epi::PERM ? ((R & ~31) + perm32(R & 31)) : R;
        voffA[i] = (unsigned)(R * K + C) * 2u; voffB[i] = (unsigned)(Rb * K + C) * 2u; }
    const size_t kstep = (size_t)(BK * 2);
    const size_t hstep = (size_t)HALF * K * 2;
    const size_t tstep = 2 * hstep;
    const unsigned ldsw = (unsigned)wid * 1024u;
    const int aoff = lds_byte(wr * 64 + fr, fq * 8), boff = lds_byte(wc * 32 + fr, fq * 8);
#define PG8_SA(b, h) (((b) * 2 + (h)) * HTB)
#define PG8_SB(b, h) ((4 + (b) * 2 + (h)) * HTB)
#define PG8_STAGE(bufoff, gbase, voff) do { _Pragma("unroll") for (int _i = 0; _i < 2; ++_i) \
        __builtin_amdgcn_global_load_lds((const unsigned*)((const char*)(gbase) + (voff)[_i]), (PG8_LAS unsigned*)(lds + (bufoff) + ldsw + _i * 8192), 16, 0, 0); } while (0)
#define PG8_LDA(dst, b, h) do { _Pragma("unroll") for (int m = 0; m < 4; ++m) _Pragma("unroll") for (int k = 0; k < 2; ++k) dst[m][k] = *(const PG8_LAS bf16x8*)(lds + PG8_SA(b, h) + aoff + m * 2048 + k * 1024); } while (0)
#define PG8_LDB(dst, b, h) do { _Pragma("unroll") for (int n = 0; n < 2; ++n) _Pragma("unroll") for (int k = 0; k < 2; ++k) dst[n][k] = *(const PG8_LAS bf16x8*)(lds + PG8_SB(b, h) + boff + n * 2048 + k * 1024); } while (0)
#define PG8_MMA(ai, bj, At, Bt) do { __builtin_amdgcn_s_setprio(1); _Pragma("unroll") for (int m = 0; m < 4; ++m) _Pragma("unroll") for (int n = 0; n < 2; ++n) _Pragma("unroll") for (int k = 0; k < 2; ++k) \
        acc[ai][bj][m][n] = __builtin_amdgcn_mfma_f32_16x16x32_bf16(Bt[n][k], At[m][k], acc[ai][bj][m][n], 0, 0, 0); __builtin_amdgcn_s_setprio(0); } while (0)
#define PG8_WAIT_V(n) asm volatile("s_waitcnt vmcnt(" #n ")" ::: "memory")
#define PG8_WAIT_L(n) asm volatile("s_waitcnt lgkmcnt(" #n ")" ::: "memory")
#define PG8_BAR __builtin_amdgcn_s_barrier()
#define PG8_SCHED __builtin_amdgcn_sched_barrier(0)
    Unit cur, nxt; int ui = 0;
    if (!S.next(0, cur)) return;
    f32x4 acc[2][2][4][2];
#pragma unroll
    for (int a = 0; a < 2; ++a)
#pragma unroll
        for (int b = 0; b < 2; ++b)
#pragma unroll
            for (int m = 0; m < 4; ++m)
#pragma unroll
                for (int n = 0; n < 2; ++n) acc[a][b][m][n] = (f32x4){0.f, 0.f, 0.f, 0.f};
    bf16x8 At[4][2], B0[2][2], B1[2][2];
    const char* cA = (const char*)g.A + (size_t)cur.pm * tstep; const char* cB = (const char*)g.Bt + (size_t)cur.pn * tstep;
    PG8_STAGE(PG8_SB(0, 0), cB, voffB); PG8_STAGE(PG8_SB(0, 1), cB + hstep, voffB); PG8_STAGE(PG8_SA(0, 0), cA, voffA); PG8_STAGE(PG8_SA(0, 1), cA + hstep, voffA);
    if (wr == 1) PG8_BAR;
    PG8_WAIT_V(2); PG8_BAR;
    PG8_STAGE(PG8_SB(1, 0), cB + kstep, voffB); PG8_STAGE(PG8_SA(1, 0), cA + kstep, voffA); PG8_STAGE(PG8_SB(1, 1), cB + hstep + kstep, voffB);
    PG8_WAIT_V(6); PG8_BAR;
    for (;;) {
        const bool has_next = S.next(ui + 1, nxt);
        const char* nA = has_next ? (const char*)g.A + (size_t)nxt.pm * tstep : cA; const char* nB = has_next ? (const char*)g.Bt + (size_t)nxt.pn * tstep : cB;
        for (int t = 0; t < nt; t += 2) {
            const bool last = (t == nt - 2);
            const char* a1 = cA + (size_t)(t + 1) * kstep;
            const char* a2 = last ? nA : cA + (size_t)(t + 2) * kstep; const char* b2 = last ? nB : cB + (size_t)(t + 2) * kstep;
            const char* a3 = a2 + kstep; const char* b3 = b2 + kstep;
            PG8_LDB(B0, 0, 0); PG8_LDB(B1, 0, 1); PG8_SCHED; PG8_LDA(At, 0, 0); PG8_STAGE(PG8_SA(1, 1), a1 + hstep, voffA);
            PG8_WAIT_V(8); PG8_WAIT_L(0); PG8_BAR; PG8_MMA(0, 0, At, B0); PG8_MMA(0, 1, At, B1); PG8_BAR; PG8_SCHED;
            PG8_LDA(At, 0, 1); PG8_STAGE(PG8_SB(0, 0), b2, voffB); PG8_STAGE(PG8_SB(0, 1), b2 + hstep, voffB); PG8_STAGE(PG8_SA(0, 0), a2, voffA);
            PG8_WAIT_V(8); PG8_WAIT_L(0); PG8_BAR; PG8_MMA(1, 0, At, B0); PG8_MMA(1, 1, At, B1); PG8_BAR; PG8_SCHED;
            PG8_LDB(B0, 1, 0); PG8_LDB(B1, 1, 1); PG8_SCHED; PG8_LDA(At, 1, 0); PG8_STAGE(PG8_SA(0, 1), a2 + hstep, voffA);
            PG8_WAIT_V(8); PG8_WAIT_L(0); PG8_BAR; PG8_MMA(0, 0, At, B0); PG8_MMA(0, 1, At, B1); PG8_BAR; PG8_SCHED;
            PG8_LDA(At, 1, 1); PG8_STAGE(PG8_SB(1, 0), b3, voffB); PG8_STAGE(PG8_SB(1, 1), b3 + hstep, voffB); PG8_STAGE(PG8_SA(1, 0), a3, voffA);
            PG8_WAIT_V(8); PG8_WAIT_L(0); PG8_BAR; PG8_MMA(1, 0, At, B0); PG8_MMA(1, 1, At, B1); PG8_BAR; PG8_SCHED;
        }
        if (wr == 0) PG8_BAR;
        E(acc, cur, wr, wc, fr, fq, (PG8_LAS float*)(lds + 131072 + 64));
        if (!has_next) break;
        if (!S.carry(ui))
#pragma unroll
        for (int a = 0; a < 2; ++a)
#pragma unroll
            for (int b = 0; b < 2; ++b)
#pragma unroll
                for (int m = 0; m < 4; ++m)
#pragma unroll
                    for (int n = 0; n < 2; ++n) acc[a][b][m][n] = (f32x4){0.f, 0.f, 0.f, 0.f};
        cur = nxt; cA = nA; cB = nB; ++ui;
        if (wr == 1) PG8_BAR;
    }
    PG8_WAIT_V(0);
    PG8_BAR;
#undef PG8_SA
#undef PG8_SB
#undef PG8_STAGE
#undef PG8_LDA
#undef PG8_LDB
#undef PG8_MMA
#undef PG8_WAIT_V
#undef PG8_WAIT_L
#undef PG8_BAR
#undef PG8_SCHED
}
}

typedef unsigned short bf16;
typedef float f32x4 __attribute__((ext_vector_type(4)));
#define LAS __attribute__((address_space(3)))
constexpr int D = 1024, FF = 2816, NZ = 7680, NGATE = 3072, DIN = 10752;
constexpr int NTOK = 65536, MC = 16384, NCHUNK = 4, DEPTH = 2;
constexpr int NWAVES = 8, NTHR = 512;
constexpr float ALPHA = 1.41421356237309515f;
constexpr float LN_EPS = 1e-5f, GN_EPS = 1e-5f;
constexpr size_t MiB = 1u << 20;
constexpr size_t WO_W1C = 0, WO_W1D = WO_W1C + (size_t)2 * FF * D, WO_WIN = WO_W1D + (size_t)D * FF, WO_PBR = WO_WIN + (size_t)DIN * D,
                 WO_WOUT = WO_PBR + (size_t)3 * D * 512, WO_W2C = WO_WOUT + (size_t)D * D, WO_W2D = WO_W2C + (size_t)2 * FF * D, WO_END = WO_W2D + (size_t)D * FF;
constexpr size_t WS_CNT = 16384;
constexpr size_t WS_W = 1 * MiB, WS_XB = 61 * MiB  , WS_Z = 125 * MiB, WS_PART = 157 * MiB, WS_G = 365 * MiB, WS_Y = 461 * MiB, WS_LSE = 509 * MiB, WS_END = 511 * MiB;
static_assert(WS_W + WO_END * 2 <= WS_XB && WS_XB + (size_t)2 * MC * D * 2 <= WS_Z, "weights / Xb fit");
static_assert(WS_Z + (size_t)MC * NZ * 2 <= WS_G && WS_Z + (size_t)2 * MC * FF * 2 <= WS_G && WS_PART + (size_t)MC * D * 4 <= WS_G && WS_Z + (size_t)MC * D * 2 <= WS_PART, "Z overlays (H of a pair, merged, partial)");
static_assert(WS_G + (size_t)MC * NGATE * 2 <= WS_Y && WS_Y + (size_t)3 * MC * 512 * 2 <= WS_LSE && (size_t)2 * 4 * 128 * 8192 * 4 <= (size_t)MC * D * 2 && WS_LSE + (size_t)3 * MC * 8 * 4 <= WS_END, "ws map");
constexpr int LDS_BYTES = 131072 + 16384;

struct Params { const float* in[22]; float* out; unsigned char* ws; };

__device__ __forceinline__ float bf2f(bf16 v) { return __uint_as_float(((unsigned)v) << 16); }
__device__ __forceinline__ unsigned f2bf(float f) { unsigned u = __builtin_bit_cast(unsigned, f); return (u + 0x7fffu + ((u >> 16) & 1u)) >> 16; }
__device__ __forceinline__ unsigned pk2(float lo, float hi) { return f2bf(lo) | (f2bf(hi) << 16); }
__device__ __forceinline__ void unpack8(const uint4 w, float* f) {
    f[0] = pg8::bflo(w.x); f[1] = pg8::bfhi(w.x); f[2] = pg8::bflo(w.y); f[3] = pg8::bfhi(w.y);
    f[4] = pg8::bflo(w.z); f[5] = pg8::bfhi(w.z); f[6] = pg8::bflo(w.w); f[7] = pg8::bfhi(w.w);
}
__device__ __forceinline__ float wave_sum(float v) {
#pragma unroll
    for (int o = 1; o < 64; o <<= 1) v += __shfl_xor(v, o);
    return v;
}

__device__ __forceinline__ void transpose_item(const float* W, int K, int N, bf16* WT, int kb, int n0, int row_base, LAS float* scr, int lane, const float* gvec) {
    const int k0 = 64 * kb;
#pragma unroll 8
    for (int i = 0; i < 32; ++i) { const int kk = 2 * i + (lane >> 5); scr[kk * 33 + (lane & 31)] = W[(size_t)(k0 + kk) * N + n0 + (lane & 31)]; }
    asm volatile("s_waitcnt lgkmcnt(0)" ::: "memory");
    const int c = lane & 7;
#pragma unroll
    for (int j = 0; j < 4; ++j) { const int n = (lane >> 3) + 8 * j; const LAS float* s = scr + (8 * c) * 33 + n;
        uint4 o; o.x = pk2(s[0 * 33], s[1 * 33]); o.y = pk2(s[2 * 33], s[3 * 33]); o.z = pk2(s[4 * 33], s[5 * 33]); o.w = pk2(s[6 * 33], s[7 * 33]);
        *(uint4*)(WT + (size_t)(row_base + n) * K + k0 + 8 * c) = o; }
    asm volatile("s_waitcnt lgkmcnt(0)" ::: "memory");
}
__device__ __forceinline__ void convert_weights(const Params& p, int L, LAS unsigned char* lds, int G) {
    int tid = threadIdx.x; asm volatile("" : "+v"(tid));
    const int lane = tid & 63, wave = __builtin_amdgcn_readfirstlane(tid >> 6);
    const int gw = blockIdx.x * NWAVES + wave, NGW = G * NWAVES;
    LAS float* scr = (LAS float*)(lds + wave * 16384);
    bf16* WB = (bf16*)(p.ws + WS_W);
    constexpr int I_UP = (D / 64) * (FF / 32), I_DN = (FF / 64) * (D / 32), I_IN = (D / 64) * (DIN / 32), I_BR = (512 / 64) * (D / 32), I_OUT = (D / 64) * (D / 32);
    constexpr int NITEMS = 4 * I_UP + 2 * I_DN + I_IN + 3 * I_BR + I_OUT;
#pragma unroll 1
    for (int it = gw; it < NITEMS; it += NGW) {
        int r = it; const float* W; int K, N, mode = 0, row_off = 0; size_t wo; const float* gv = nullptr;
        const float* gin1 = L ? p.in[20] + (size_t)(L - 1) * D : nullptr;
        if (r < I_UP) { W = p.in[2] + (size_t)L * D * FF; K = D; N = FF; mode = 1; wo = WO_W1C; }
        else if ((r -= I_UP) < I_UP) { W = p.in[3] + (size_t)L * D * FF; K = D; N = FF; mode = 2; wo = WO_W1C; }
        else if ((r -= I_UP) < I_DN) { W = p.in[4] + (size_t)L * FF * D; K = FF; N = D; wo = WO_W1D; }
        else if ((r -= I_DN) < I_IN) { W = p.in[7] + (size_t)L * D * DIN; K = D; N = DIN; wo = WO_WIN; }
        else if ((r -= I_IN) < I_BR) { W = p.in[11] + (size_t)L * 512 * D; K = 512; N = D; wo = WO_PBR; }
        else if ((r -= I_BR) < I_BR) { W = p.in[12] + (size_t)L * 512 * D; K = 512; N = D; wo = WO_PBR; row_off = 1024; }
        else if ((r -= I_BR) < I_BR) { W = p.in[13] + (size_t)L * 512 * D; K = 512; N = D; wo = WO_PBR; row_off = 2048; }
        else if ((r -= I_BR) < I_OUT) { W = p.in[14] + (size_t)L * D * D; K = D; N = D; wo = WO_WOUT; }
        else if ((r -= I_OUT) < I_UP) { W = p.in[17] + (size_t)L * D * FF; K = D; N = FF; mode = 1; wo = WO_W2C; }
        else if ((r -= I_UP) < I_UP) { W = p.in[18] + (size_t)L * D * FF; K = D; N = FF; mode = 2; wo = WO_W2C; }
        else { r -= I_UP; W = p.in[19] + (size_t)L * FF * D; K = FF; N = D; wo = WO_W2D; }
        const int nblk = N / 32, kb = r / nblk, n0 = (r % nblk) * 32;
        int row_base = row_off + n0;
        if (mode) row_base = (n0 >> 7) * 256 + (mode == 2 ? 128 : 0) + (n0 & 127);
        int ln = lane; asm volatile("" : "+v"(ln));
        transpose_item(W, K, N, WB + wo, kb, n0, row_base, scr, ln, gv);
    }
}

__device__ __forceinline__ void convert_rows(const float* src, bf16* xb, int nrows, int gtid, int gthreads) {
    const int n4 = nrows * (D / 4);
    for (int i = gtid; i < n4; i += 4 * gthreads) {
        f32x4 v[4];
#pragma unroll
        for (int k = 0; k < 4; ++k) { const int j = i + k * gthreads; if (j < n4) v[k] = __builtin_nontemporal_load((const f32x4*)src + j); }
#pragma unroll
        for (int k = 0; k < 4; ++k) { const int j = i + k * gthreads; if (j < n4) { uint2 o; o.x = pk2(v[k].x, v[k].y); o.y = pk2(v[k].z, v[k].w); ((uint2*)xb)[j] = o; } }
    }
}
template <bool FINAL>
__device__ __forceinline__ void ln_pass(float* V, bf16* xb, float* RS, const float* g, const float* b, int nrows, int gw, int NGW, int lane) {
    f32x4 gv[4], bv[4];
#pragma unroll
    for (int j = 0; j < 4; ++j) { gv[j] = ((const f32x4*)g)[lane + 64 * j]; bv[j] = ((const f32x4*)b)[lane + 64 * j]; }
    for (int m = gw; m < nrows; m += NGW) {
        f32x4* xr = (f32x4*)(V + (size_t)m * D) + lane;
        f32x4 v[4]; float s = 0.f;
#pragma unroll
        for (int j = 0; j < 4; ++j) { v[j] = xr[64 * j]; s += (v[j].x + v[j].y) + (v[j].z + v[j].w); }
        const float mean = wave_sum(s) * (1.f / D); float s2 = 0.f;
#pragma unroll
        for (int j = 0; j < 4; ++j) { v[j] = v[j] - mean; s2 += (v[j].x * v[j].x + v[j].y * v[j].y) + (v[j].z * v[j].z + v[j].w * v[j].w); }
        const float rstd = 1.f / sqrtf(wave_sum(s2) * (1.f / D) + LN_EPS);
        if (FINAL) {
#pragma unroll
            for (int j = 0; j < 4; ++j) xr[64 * j] = v[j] * rstd * gv[j] + bv[j];
        } else {
            if (lane == 0) { float2 st; st.x = mean; st.y = rstd; *(float2*)(RS + (size_t)m * 2) = st; }
            uint2* o8 = (uint2*)(xb + (size_t)m * D) + lane;
#pragma unroll
            for (int j = 0; j < 4; ++j) { const f32x4 y = v[j] * rstd * gv[j] + bv[j]; uint2 o; o.x = pk2(y.x, y.y); o.y = pk2(y.z, y.w); o8[64 * j] = o; }
        }
    }
}

__device__ __forceinline__ void mixA_unit(const bf16* Z, bf16* Ya, int tc0, int S, int h, int tid) {
    const int ql = tid >> 3, sub = tid & 7;
    const int tc = tc0 + ql, seq0 = (tc / S) * S, t = tc - seq0;
    const bf16* zq = Z + (size_t)tc * NZ;
    const float slope = exp2f(-(float)(h + 1));
    float m = -1e30f, l = 0.f, o[8];
#pragma unroll
    for (int i = 0; i < 8; ++i) o[i] = 0.f;
#pragma unroll 1
    for (int g = 0; g < 3; ++g) {
        const int dil = 1 << (2 * g);
        float q[8]; unpack8(*(const uint4*)(zq + g * 512 + h * 64 + sub * 8), q);
#pragma unroll
        for (int i = 0; i < 8; ++i) q[i] *= 0.125f;
        const bf16* kbase = Z + (size_t)seq0 * NZ + 1536 + g * 512 + h * 64 + sub * 8;
#pragma unroll 1
        for (int jj = 0; jj <= 128; ++jj) {
            const int j = jj - 64, s = t + j * dil; const bool valid = (s >= 0) && (s < S); const int sc_ = valid ? s : t;
            const bf16* kp = kbase + (size_t)sc_ * NZ;
            float k[8], v[8]; unpack8(*(const uint4*)kp, k); unpack8(*(const uint4*)(kp + 1536), v);
            float dot = 0.f;
#pragma unroll
            for (int i = 0; i < 8; ++i) dot += q[i] * k[i];
            dot += __shfl_xor(dot, 1); dot += __shfl_xor(dot, 2); dot += __shfl_xor(dot, 4);
            const float sc = dot - slope * (float)((j < 0 ? -j : j) * dil);
            const float mn = valid ? fmaxf(m, sc) : m;
            const float corr = __expf(m - mn), pe = valid ? __expf(sc - mn) : 0.f;
            l = l * corr + pe;
#pragma unroll
            for (int i = 0; i < 8; ++i) o[i] = o[i] * corr + pe * v[i];
            m = mn;
        }
    }
    const float inv = 1.f / l;
    uint4 w; w.x = pk2(o[0] * inv, o[1] * inv); w.y = pk2(o[2] * inv, o[3] * inv); w.z = pk2(o[4] * inv, o[5] * inv); w.w = pk2(o[6] * inv, o[7] * inv);
    *(uint4*)(Ya + (size_t)tc * 512 + h * 64 + sub * 8) = w;
}
__device__ __forceinline__ void mixC_unit(const bf16* Z, bf16* Yc, const float* rpb, int tc0, int S, int h, int tid) {
    const int ql = tid >> 3, sub = tid & 7;
    const int tc = tc0 + ql, seq0 = (tc / S) * S, t = tc - seq0;
    const int rows = S / 64, qr = t >> 6, qc = t & 63;
    int rs = qr - 4; rs = rs < 0 ? 0 : (rs > rows - 8 ? rows - 8 : rs);
    int cs = qc - 8; cs = cs < 0 ? 0 : (cs > 48 ? 48 : cs);
    float q[8]; unpack8(*(const uint4*)(Z + (size_t)tc * NZ + 6144 + h * 64 + sub * 8), q);
#pragma unroll
    for (int i = 0; i < 8; ++i) q[i] *= 0.125f;
    const bf16* kbase = Z + (size_t)seq0 * NZ + 6656 + h * 64 + sub * 8;
    const float* rb = rpb + h * 15 * 31;
    float m = -1e30f, l = 0.f, o[8];
#pragma unroll
    for (int i = 0; i < 8; ++i) o[i] = 0.f;
#pragma unroll 2
    for (int kk = 0; kk < 128; ++kk) {
        const int kr = rs + (kk >> 4), kc = cs + (kk & 15), s = kr * 64 + kc;
        const bf16* kp = kbase + (size_t)s * NZ;
        float k[8], v[8]; unpack8(*(const uint4*)kp, k); unpack8(*(const uint4*)(kp + 512), v);
        float dot = 0.f;
#pragma unroll
        for (int i = 0; i < 8; ++i) dot += q[i] * k[i];
        dot += __shfl_xor(dot, 1); dot += __shfl_xor(dot, 2); dot += __shfl_xor(dot, 4);
        const float sc = dot + rb[(kr - qr + 7) * 31 + (kc - qc + 15)];
        const float mn = fmaxf(m, sc);
        const float corr = __expf(m - mn), pe = __expf(sc - mn);
        l = l * corr + pe;
#pragma unroll
        for (int i = 0; i < 8; ++i) o[i] = o[i] * corr + pe * v[i];
        m = mn;
    }
    const float inv = 1.f / l;
    uint4 w; w.x = pk2(o[0] * inv, o[1] * inv); w.y = pk2(o[2] * inv, o[3] * inv); w.z = pk2(o[4] * inv, o[5] * inv); w.w = pk2(o[6] * inv, o[7] * inv);
    *(uint4*)(Yc + (size_t)tc * 512 + h * 64 + sub * 8) = w;
}
__device__ __forceinline__ void mixB1_unit(const bf16* Z, float* ST, int gn, int hb, float lgf, float lgb, int tid) {
    const int d = tid >> 3, eb = (tid & 7) * 16;
    float f[16], b[16];
#pragma unroll
    for (int i = 0; i < 16; ++i) { f[i] = 0.f; b[i] = 0.f; }
    const bf16* zb = Z + (size_t)gn * 128 * NZ;
#pragma unroll 2
    for (int j = 0; j < 128; ++j) {
        const bf16* zr = zb + (size_t)j * NZ;
        const float kd = bf2f(zr[4864 + hb * 64 + d]) * 0.125f;
        float v[16]; unpack8(*(const uint4*)(zr + 5120 + hb * 128 + eb), v); unpack8(*(const uint4*)(zr + 5120 + hb * 128 + eb + 8), v + 8);
        const float wf = kd * __expf(lgf * (float)(127 - j)), wb = kd * __expf(lgb * (float)j);
#pragma unroll
        for (int i = 0; i < 16; ++i) { f[i] += wf * v[i]; b[i] += wb * v[i]; }
    }
    float* pf = ST + ((size_t)(0 * 4 + hb) * 128 + gn) * 8192 + d * 128 + eb;
    float* pb = ST + ((size_t)(1 * 4 + hb) * 128 + gn) * 8192 + d * 128 + eb;
#pragma unroll
    for (int i = 0; i < 4; ++i) { ((f32x4*)pf)[i] = (f32x4){f[4 * i], f[4 * i + 1], f[4 * i + 2], f[4 * i + 3]}; ((f32x4*)pb)[i] = (f32x4){b[4 * i], b[4 * i + 1], b[4 * i + 2], b[4 * i + 3]}; }
}
__device__ __forceinline__ float log_sigmoid2_(float x) { return -log1pf(__expf(-x)); }
__device__ __forceinline__ void mixB2(float* ST, int S, int nseq, const float* lgf4, const float* lgb4, int gtid, int gthreads) {
    const int N = S / 128, total = 2 * 4 * nseq * 8192;
    for (int id = gtid; id < total; id += gthreads) {
        const int el = id & 8191; int r = id >> 13; const int sq = r % nseq; r /= nseq; const int hb = r & 3, dir = r >> 2;
        const float lg = log_sigmoid2_(dir ? lgb4[hb] : lgf4[hb]); const float decay = __expf(lg * 128.f);
        float* p = ST + ((size_t)(dir * 4 + hb) * 128 + sq * N) * 8192 + el;
        float s = 0.f;
        for (int n0 = 0; n0 < N; n0 += 8) {
            float tmp[8];
#pragma unroll
            for (int i = 0; i < 8; ++i) { const int n = dir ? (N - 1 - (n0 + i)) : (n0 + i); tmp[i] = p[(size_t)n * 8192]; }
#pragma unroll
            for (int i = 0; i < 8; ++i) { const int n = dir ? (N - 1 - (n0 + i)) : (n0 + i); p[(size_t)n * 8192] = s; s = decay * s + tmp[i]; }
        }
    }
}
__device__ __forceinline__ void mixB3_unit(const bf16* Z, const float* ST, bf16* Yb, int gn, int hb, float lgf, float lgb, int tid) {
    const int i = tid >> 2, sub = tid & 3;
    const int tc = gn * 128 + i;
    const bf16* zq = Z + (size_t)tc * NZ;
    float q[64];
#pragma unroll
    for (int c = 0; c < 8; ++c) unpack8(*(const uint4*)(zq + 4608 + hb * 64 + c * 8), q + c * 8);
    float o[32];
#pragma unroll
    for (int e = 0; e < 32; ++e) o[e] = 0.f;
    const bf16* zb = Z + (size_t)gn * 128 * NZ;
#pragma unroll 1
    for (int j = 0; j < 128; ++j) {
        const bf16* zr = zb + (size_t)j * NZ;
        float dot = 0.f;
#pragma unroll
        for (int c = 0; c < 8; ++c) { float k[8]; unpack8(*(const uint4*)(zr + 4864 + hb * 64 + c * 8), k);
#pragma unroll
            for (int x = 0; x < 8; ++x) dot += q[c * 8 + x] * k[x]; }
        const float w = dot * 0.125f * (j <= i ? __expf(lgf * (float)(i - j)) : __expf(lgb * (float)(j - i)));
#pragma unroll
        for (int c = 0; c < 4; ++c) { float v[8]; unpack8(*(const uint4*)(zr + 5120 + hb * 128 + sub * 32 + c * 8), v);
#pragma unroll
            for (int x = 0; x < 8; ++x) o[c * 8 + x] += w * v[x]; }
    }
    const float cf = __expf(lgf * (float)(i + 1)), cb = __expf(lgb * (float)(128 - i));
    const float* Sf = ST + ((size_t)(0 * 4 + hb) * 128 + gn) * 8192 + sub * 32;
    const float* Sb = ST + ((size_t)(1 * 4 + hb) * 128 + gn) * 8192 + sub * 32;
#pragma unroll 2
    for (int d = 0; d < 64; ++d) {
        const float qd = bf2f(zq[4608 + hb * 64 + d]); const float a = qd * cf, b = qd * cb;
#pragma unroll
        for (int c = 0; c < 8; ++c) { const f32x4 sf = ((const f32x4*)(Sf + d * 128))[c], sb = ((const f32x4*)(Sb + d * 128))[c];
            o[4 * c] += a * sf.x + b * sb.x; o[4 * c + 1] += a * sf.y + b * sb.y; o[4 * c + 2] += a * sf.z + b * sb.z; o[4 * c + 3] += a * sf.w + b * sb.w; }
    }
    float s1 = 0.f;
#pragma unroll
    for (int e = 0; e < 32; ++e) s1 += o[e];
    s1 += __shfl_xor(s1, 1); s1 += __shfl_xor(s1, 2);
    const float mu = s1 * (1.f / 128.f);
    float s2 = 0.f;
#pragma unroll
    for (int e = 0; e < 32; ++e) { o[e] -= mu; s2 += o[e] * o[e]; }
    s2 += __shfl_xor(s2, 1); s2 += __shfl_xor(s2, 2);
    const float rstd = 1.f / sqrtf(s2 * (1.f / 128.f) + GN_EPS);
#pragma unroll
    for (int c = 0; c < 4; ++c) {
        float gt[8]; unpack8(*(const uint4*)(zq + 5632 + hb * 128 + sub * 32 + c * 8), gt);
        float y[8];
#pragma unroll
        for (int x = 0; x < 8; ++x) y[x] = o[c * 8 + x] * rstd * gt[x] * pg8::sigmoidf_(gt[x]);
        uint4 w; w.x = pk2(y[0], y[1]); w.y = pk2(y[2], y[3]); w.z = pk2(y[4], y[5]); w.w = pk2(y[6], y[7]);
        *(uint4*)(Yb + (size_t)tc * 512 + hb * 128 + sub * 32 + c * 8) = w;
    }
}

typedef short bf16x8_t __attribute__((ext_vector_type(8)));
typedef short s16x4_t __attribute__((ext_vector_type(4)));
__device__ __forceinline__ s16x4_t trread(LAS unsigned char* p) { return __builtin_amdgcn_ds_read_tr16_b64_v4i16((LAS s16x4_t*)p); }
__device__ __forceinline__ bf16x8_t cat4(s16x4_t a, s16x4_t b) { return (bf16x8_t){a[0], a[1], a[2], a[3], b[0], b[1], b[2], b[3]}; }
__device__ __forceinline__ bf16x8_t packp(f32x4 a, f32x4 b) {
    uint4 w; w.x = pg8::cvt_pk_bf16(a[0], a[1]); w.y = pg8::cvt_pk_bf16(a[2], a[3]); w.z = pg8::cvt_pk_bf16(b[0], b[1]); w.w = pg8::cvt_pk_bf16(b[2], b[3]);
    return __builtin_bit_cast(bf16x8_t, w);
}
constexpr int KPITCH = 144;
constexpr int A_ROWS = 400, A_VOFF = A_ROWS * KPITCH;
constexpr int A_TOT = 2 * A_ROWS * 8, A_NIT = (A_TOT + NTHR - 1) / NTHR;
__device__ __forceinline__ void mixA_load(const bf16* Z, int u, int S, int tid, pg8::u32x4 (&buf)[A_NIT]) {
    const int g = u >> 9, h = u & 7, tt = (u >> 3) & 63;
    const int dil = 1 << (2 * g), Lg = S / dil, tps = S >> 8, tpr = Lg >> 8;
    const int sq = tt / tps, x = tt - sq * tps, r = x / tpr, i0 = (x - r * tpr) << 8;
    const bf16* zk = Z + (size_t)(sq * S) * NZ + 1536 + g * 512 + h * 64;
#pragma unroll
    for (int i = 0; i < A_NIT; ++i) {
        const int c = tid + i * NTHR; const int mat = c >= A_ROWS * 8, cc = c - mat * A_ROWS * 8, row = cc >> 3, ch = cc & 7, idx = i0 - 64 + row;
        buf[i] = (pg8::u32x4){0u, 0u, 0u, 0u};
        if (c < A_TOT && idx >= 0 && idx < Lg) buf[i] = *(const pg8::u32x4*)(zk + (size_t)(idx * dil + r) * NZ + mat * 1536 + ch * 8);
    }
}
__device__ __forceinline__ void mixA_store(LAS unsigned char* lds, int tid, const pg8::u32x4 (&buf)[A_NIT]) {
#pragma unroll
    for (int i = 0; i < A_NIT; ++i) {
        const int c = tid + i * NTHR; const int mat = c >= A_ROWS * 8, cc = c - mat * A_ROWS * 8, row = cc >> 3, ch = cc & 7;
        if (c < A_TOT) *(LAS pg8::u32x4*)(lds + mat * A_VOFF + row * KPITCH + ch * 16) = buf[i];
    }
}
__device__ __forceinline__ void mixA_compute(bf16* Z, float* LSE, LAS unsigned char* lds, int u, int S, int tid) {
    const int g = u >> 9, h = u & 7, tt = (u >> 3) & 63;
    const int dil = 1 << (2 * g), Lg = S / dil, tps = S >> 8, tpr = Lg >> 8;
    const int sq = tt / tps, x = tt - sq * tps, r = x / tpr, i0 = (x - r * tpr) << 8;
    const int seq0 = sq * S;
    const int lane = tid & 63, w = tid >> 6, n = lane & 15, q = lane >> 4;
#pragma unroll
    for (int qt = 0; qt < 2; ++qt) {
    const int wt = 2 * w + qt;
    const int iq = i0 + 16 * wt + n, tokc = seq0 + iq * dil + r;
    bf16* qp = Z + (size_t)tokc * NZ + g * 512 + h * 64;
    const bf16x8_t qf0 = *(const bf16x8_t*)(qp + 8 * q), qf1 = *(const bf16x8_t*)(qp + 32 + 8 * q);
    f32x4 s[10];
#pragma unroll
    for (int t = 0; t < 9; ++t) {
        LAS unsigned char* kp = lds + (16 * wt + 16 * t + n) * KPITCH + q * 16;
        const bf16x8_t kf0 = *(LAS bf16x8_t*)kp, kf1 = *(LAS bf16x8_t*)(kp + 64);
        f32x4 a = {0.f, 0.f, 0.f, 0.f};
        a = __builtin_amdgcn_mfma_f32_16x16x32_bf16(kf0, qf0, a, 0, 0, 0);
        s[t] = __builtin_amdgcn_mfma_f32_16x16x32_bf16(kf1, qf1, a, 0, 0, 0);
    }
    s[9] = (f32x4){0.f, 0.f, 0.f, 0.f};
    const float slope = exp2f(-(float)(h + 1)) * (float)dil;
    float m = -1e30f;
#pragma unroll
    for (int t = 0; t < 9; ++t)
#pragma unroll
        for (int j = 0; j < 4; ++j) {
            const int rel = 16 * t + 4 * q + j - 64 - n, idxk = i0 - 64 + 16 * wt + 16 * t + 4 * q + j;
            const bool valid = (rel >= -64) && (rel <= 64) && (idxk >= 0) && (idxk < Lg);
            const float sc = s[t][j] * 0.125f - slope * (float)(rel < 0 ? -rel : rel);
            s[t][j] = valid ? sc : -1e30f; m = fmaxf(m, s[t][j]);
        }
    m = fmaxf(m, __shfl_xor(m, 16)); m = fmaxf(m, __shfl_xor(m, 32));
    float l = 0.f;
#pragma unroll
    for (int t = 0; t < 9; ++t)
#pragma unroll
        for (int j = 0; j < 4; ++j) { const float pe = __expf(s[t][j] - m); s[t][j] = pe; l += pe; }
    l += __shfl_xor(l, 16); l += __shfl_xor(l, 32);
    f32x4 o[4];
#pragma unroll
    for (int dt = 0; dt < 4; ++dt) o[dt] = (f32x4){0.f, 0.f, 0.f, 0.f};
    LAS unsigned char* vb = lds + A_VOFF + (16 * wt + 4 * q + ((lane >> 2) & 3)) * KPITCH + 8 * (lane & 3);
#pragma unroll
    for (int G = 0; G < 5; ++G) {
        const bf16x8_t pb = packp(s[2 * G], s[2 * G + 1]);
#pragma unroll
        for (int dt = 0; dt < 4; ++dt) {
            const s16x4_t lo = trread(vb + (32 * G) * KPITCH + dt * 32), hi = trread(vb + (32 * G + 16) * KPITCH + dt * 32);
            o[dt] = __builtin_amdgcn_mfma_f32_16x16x32_bf16(cat4(lo, hi), pb, o[dt], 0, 0, 0);
        }
    }
    const float inv = 1.f / l;
#pragma unroll
    for (int dt = 0; dt < 4; ++dt) { uint2 wv; wv.x = pg8::cvt_pk_bf16(o[dt][0] * inv, o[dt][1] * inv); wv.y = pg8::cvt_pk_bf16(o[dt][2] * inv, o[dt][3] * inv);
        *(uint2*)(qp + dt * 16 + 4 * q) = wv; }
    if (q == 0) LSE[((size_t)g * MC + tokc) * 8 + h] = m + __logf(l);
    }
}
__device__ __forceinline__ void mixA_merge(const bf16* Z, const float* LSE, bf16* Ya, int gtid, int gthreads) {
    for (int it = gtid; it < MC * 64; it += gthreads) {
        const int tok = it >> 6, h = (it >> 3) & 7, ch = it & 7;
        const float l0 = LSE[((size_t)0 * MC + tok) * 8 + h], l1 = LSE[((size_t)1 * MC + tok) * 8 + h], l2 = LSE[((size_t)2 * MC + tok) * 8 + h];
        const float mx = fmaxf(l0, fmaxf(l1, l2));
        float w0 = __expf(l0 - mx), w1 = __expf(l1 - mx), w2 = __expf(l2 - mx); const float inv = 1.f / (w0 + w1 + w2); w0 *= inv; w1 *= inv; w2 *= inv;
        const bf16* zp = Z + (size_t)tok * NZ + h * 64 + ch * 8;
        float a[8], b[8], c[8]; unpack8(*(const uint4*)zp, a); unpack8(*(const uint4*)(zp + 512), b); unpack8(*(const uint4*)(zp + 1024), c);
        uint4 wv; wv.x = pk2(w0 * a[0] + w1 * b[0] + w2 * c[0], w0 * a[1] + w1 * b[1] + w2 * c[1]); wv.y = pk2(w0 * a[2] + w1 * b[2] + w2 * c[2], w0 * a[3] + w1 * b[3] + w2 * c[3]);
        wv.z = pk2(w0 * a[4] + w1 * b[4] + w2 * c[4], w0 * a[5] + w1 * b[5] + w2 * c[5]); wv.w = pk2(w0 * a[6] + w1 * b[6] + w2 * c[6], w0 * a[7] + w1 * b[7] + w2 * c[7]);
        *(uint4*)(Ya + (size_t)tok * 512 + h * 64 + ch * 8) = wv;
    }
}
constexpr int C_ROWS = 704;
__device__ __forceinline__ void mixC_mfma_unit(const bf16* Z, bf16* Yc, const float* rpb, LAS unsigned char* lds, int u, int S, int tid) {
    const int h = u & 7, rp = u >> 3, rps = S >> 8, sq = rp / rps, np = rp - sq * rps, seq0 = sq * S, rows = S >> 6;
    const int lane = tid & 63, w = tid >> 6, n = lane & 15, q = lane >> 4;
    int rb = 4 * np - 4; rb = rb < 0 ? 0 : (rb > rows - 11 ? rows - 11 : rb);
    const bf16* zk = Z + (size_t)seq0 * NZ + 6656 + h * 64;
    __syncthreads();
    {
        constexpr int NIT = C_ROWS * 8 / NTHR;
        pg8::u32x4 buf[NIT];
#pragma unroll
        for (int i = 0; i < NIT; ++i) { const int c = tid + i * NTHR, row = c >> 3, ch = c & 7; buf[i] = *(const pg8::u32x4*)(zk + (size_t)(rb * 64 + row) * NZ + 512 + ch * 8); }
#pragma unroll
        for (int i = 0; i < NIT; ++i) { const int c = tid + i * NTHR, row = c >> 3, ch = c & 7; *(LAS pg8::u32x4*)(lds + row * KPITCH + ch * 16) = buf[i]; }
        if (tid < 15 * 31) ((LAS float*)(lds + C_ROWS * KPITCH))[tid] = rpb[h * 15 * 31 + tid];
    }
    __syncthreads();
#pragma unroll
    for (int qt = 0; qt < 2; ++qt) {
    const int qr = 4 * np + 2 * qt + (w >> 2), cb = w & 3, qc = cb * 16 + n;
    int rs = qr - 4; rs = rs < 0 ? 0 : (rs > rows - 8 ? rows - 8 : rs);
    int cbs = cb * 16 - 8; cbs = cbs < 0 ? 0 : (cbs > 32 ? 32 : cbs);
    int cs = qc - 8; cs = cs < 0 ? 0 : (cs > 48 ? 48 : cs);
    const int tokc = seq0 + qr * 64 + qc;
    const bf16* qp = Z + (size_t)tokc * NZ + 6144 + h * 64;
    const bf16x8_t qf0 = *(const bf16x8_t*)(qp + 8 * q), qf1 = *(const bf16x8_t*)(qp + 32 + 8 * q);
    f32x4 s[16];
#pragma unroll
    for (int hf = 0; hf < 2; ++hf) {
        bf16x8_t kf[8][2];
#pragma unroll
        for (int tt = 0; tt < 8; ++tt) { const int t = 8 * hf + tt;
            const bf16* kp = zk + (size_t)((rs + (t >> 1)) * 64 + cbs + (t & 1) * 16 + n) * NZ + 8 * q;
            kf[tt][0] = *(const bf16x8_t*)kp; kf[tt][1] = *(const bf16x8_t*)(kp + 32); }
#pragma unroll
        for (int tt = 0; tt < 8; ++tt) {
            f32x4 a = {0.f, 0.f, 0.f, 0.f};
            a = __builtin_amdgcn_mfma_f32_16x16x32_bf16(kf[tt][0], qf0, a, 0, 0, 0);
            s[8 * hf + tt] = __builtin_amdgcn_mfma_f32_16x16x32_bf16(kf[tt][1], qf1, a, 0, 0, 0);
        }
        __builtin_amdgcn_sched_barrier(0);
    }
    const LAS float* rbp = (const LAS float*)(lds + C_ROWS * KPITCH);
    float m = -1e30f;
#pragma unroll
    for (int t = 0; t < 16; ++t)
#pragma unroll
        for (int j = 0; j < 4; ++j) {
            const int kr = rs + (t >> 1), kc = cbs + (t & 1) * 16 + 4 * q + j;
            const bool valid = (kc >= cs) && (kc < cs + 16);
            int dc = kc - qc + 15; dc = dc < 0 ? 0 : (dc > 30 ? 30 : dc);
            const float sc = s[t][j] * 0.125f + rbp[(kr - qr + 7) * 31 + dc];
            s[t][j] = valid ? sc : -1e30f; m = fmaxf(m, s[t][j]);
        }
    m = fmaxf(m, __shfl_xor(m, 16)); m = fmaxf(m, __shfl_xor(m, 32));
    float l = 0.f;
#pragma unroll
    for (int t = 0; t < 16; ++t)
#pragma unroll
        for (int j = 0; j < 4; ++j) { const float pe = __expf(s[t][j] - m); s[t][j] = pe; l += pe; }
    l += __shfl_xor(l, 16); l += __shfl_xor(l, 32);
    f32x4 o[4];
#pragma unroll
    for (int dt = 0; dt < 4; ++dt) o[dt] = (f32x4){0.f, 0.f, 0.f, 0.f};
    LAS unsigned char* vb = lds + ((rs - rb) * 64 + cbs + 4 * q + ((lane >> 2) & 3)) * KPITCH + 8 * (lane & 3);
#pragma unroll
    for (int G = 0; G < 8; ++G) {
        const bf16x8_t pb = packp(s[2 * G], s[2 * G + 1]);
#pragma unroll
        for (int dt = 0; dt < 4; ++dt) {
            const s16x4_t lo = trread(vb + (64 * G) * KPITCH + dt * 32), hi = trread(vb + (64 * G + 16) * KPITCH + dt * 32);
            o[dt] = __builtin_amdgcn_mfma_f32_16x16x32_bf16(cat4(lo, hi), pb, o[dt], 0, 0, 0);
        }
    }
    const float inv = 1.f / l;
    bf16* yp = Yc + (size_t)tokc * 512 + h * 64;
#pragma unroll
    for (int dt = 0; dt < 4; ++dt) { uint2 wv; wv.x = pg8::cvt_pk_bf16(o[dt][0] * inv, o[dt][1] * inv); wv.y = pg8::cvt_pk_bf16(o[dt][2] * inv, o[dt][3] * inv);
        *(uint2*)(yp + dt * 16 + 4 * q) = wv; }
    }
}

constexpr int VPITCH = 288;
constexpr int B1_V = 0, B1_KF = 128 * VPITCH, B1_KB = B1_KF + 128 * KPITCH;
__device__ __forceinline__ void mixB1_mfma_unit(const bf16* Z, float* ST, LAS unsigned char* lds, int gn, int hb, float lgf, float lgb, int tid) {
    const int lane = tid & 63, w = tid >> 6, n = lane & 15, q = lane >> 4;
    const bf16* zb = Z + (size_t)gn * 128 * NZ;
    __syncthreads();
    {
        pg8::u32x4 vbuf[4]; uint4 kbuf[2];
#pragma unroll
        for (int i = 0; i < 4; ++i) { const int c = tid + i * NTHR, row = c >> 4, ch = c & 15; vbuf[i] = *(const pg8::u32x4*)(zb + (size_t)row * NZ + 5120 + hb * 128 + ch * 8); }
#pragma unroll
        for (int i = 0; i < 2; ++i) { const int c = tid + i * NTHR, row = c >> 3, ch = c & 7; kbuf[i] = *(const uint4*)(zb + (size_t)row * NZ + 4864 + hb * 64 + ch * 8); }
#pragma unroll
        for (int i = 0; i < 4; ++i) { const int c = tid + i * NTHR, row = c >> 4, ch = c & 15; *(LAS pg8::u32x4*)(lds + B1_V + row * VPITCH + ch * 16) = vbuf[i]; }
#pragma unroll
        for (int i = 0; i < 2; ++i) { const int c = tid + i * NTHR, row = c >> 3, ch = c & 7;
            float k[8]; unpack8(kbuf[i], k);
            const float wf = 0.125f * __expf(lgf * (float)(127 - row)), wb = 0.125f * __expf(lgb * (float)row);
            pg8::u32x4 a, b;
            a.x = pg8::cvt_pk_bf16(k[0] * wf, k[1] * wf); a.y = pg8::cvt_pk_bf16(k[2] * wf, k[3] * wf); a.z = pg8::cvt_pk_bf16(k[4] * wf, k[5] * wf); a.w = pg8::cvt_pk_bf16(k[6] * wf, k[7] * wf);
            b.x = pg8::cvt_pk_bf16(k[0] * wb, k[1] * wb); b.y = pg8::cvt_pk_bf16(k[2] * wb, k[3] * wb); b.z = pg8::cvt_pk_bf16(k[4] * wb, k[5] * wb); b.w = pg8::cvt_pk_bf16(k[6] * wb, k[7] * wb);
            *(LAS pg8::u32x4*)(lds + B1_KF + row * KPITCH + ch * 16) = a; *(LAS pg8::u32x4*)(lds + B1_KB + row * KPITCH + ch * 16) = b; }
    }
    __syncthreads();
    f32x4 af[4], ab[4];
#pragma unroll
    for (int dt = 0; dt < 4; ++dt) { af[dt] = (f32x4){0.f, 0.f, 0.f, 0.f}; ab[dt] = (f32x4){0.f, 0.f, 0.f, 0.f}; }
    const int rsel = 4 * q + ((lane >> 2) & 3), csel = 8 * (lane & 3);
#pragma unroll
    for (int js = 0; js < 4; ++js) {
        LAS unsigned char* vp = lds + B1_V + (32 * js + rsel) * VPITCH + w * 32 + csel;
        const bf16x8_t va = cat4(trread(vp), trread(vp + 16 * VPITCH));
#pragma unroll
        for (int dt = 0; dt < 4; ++dt) {
            LAS unsigned char* kf = lds + B1_KF + (32 * js + rsel) * KPITCH + dt * 32 + csel;
            LAS unsigned char* kb = lds + B1_KB + (32 * js + rsel) * KPITCH + dt * 32 + csel;
            af[dt] = __builtin_amdgcn_mfma_f32_16x16x32_bf16(va, cat4(trread(kf), trread(kf + 16 * KPITCH)), af[dt], 0, 0, 0);
            ab[dt] = __builtin_amdgcn_mfma_f32_16x16x32_bf16(va, cat4(trread(kb), trread(kb + 16 * KPITCH)), ab[dt], 0, 0, 0);
        }
    }
    float* pf = ST + ((size_t)(0 * 4 + hb) * 128 + gn) * 8192 + 16 * w + 4 * q;
    float* pb = ST + ((size_t)(1 * 4 + hb) * 128 + gn) * 8192 + 16 * w + 4 * q;
#pragma unroll
    for (int dt = 0; dt < 4; ++dt) { *(f32x4*)(pf + (dt * 16 + n) * 128) = af[dt]; *(f32x4*)(pb + (dt * 16 + n) * 128) = ab[dt]; }
}
constexpr int B3_K = 0, B3_V = 128 * KPITCH, B3_SF = B3_V + 128 * VPITCH, B3_SB = B3_SF + 64 * VPITCH;
__device__ __forceinline__ void mixB3_mfma_unit(const bf16* Z, const float* ST, bf16* Yb, LAS unsigned char* lds, int gn, int hb, float lgf, float lgb, int tid) {
    const int lane = tid & 63, w = tid >> 6, n = lane & 15, q = lane >> 4;
    const bf16* zb = Z + (size_t)gn * 128 * NZ;
    const float* Sf = ST + ((size_t)(0 * 4 + hb) * 128 + gn) * 8192;
    const float* Sb = ST + ((size_t)(1 * 4 + hb) * 128 + gn) * 8192;
    __syncthreads();
    {
        pg8::u32x4 kbuf[2], vbuf[4]; f32x4 sbuf[4][2];
#pragma unroll
        for (int i = 0; i < 2; ++i) { const int c = tid + i * NTHR, row = c >> 3, ch = c & 7; kbuf[i] = *(const pg8::u32x4*)(zb + (size_t)row * NZ + 4864 + hb * 64 + ch * 8); }
#pragma unroll
        for (int i = 0; i < 4; ++i) { const int c = tid + i * NTHR, row = c >> 4, ch = c & 15; vbuf[i] = *(const pg8::u32x4*)(zb + (size_t)row * NZ + 5120 + hb * 128 + ch * 8); }
#pragma unroll
        for (int i = 0; i < 4; ++i) { const int c = tid + i * NTHR, dir = c >> 10, cc = c & 1023, row = cc >> 4, ch = cc & 15;
            const float* sp = (dir ? Sb : Sf) + row * 128 + ch * 8; sbuf[i][0] = *(const f32x4*)sp; sbuf[i][1] = *(const f32x4*)(sp + 4); }
#pragma unroll
        for (int i = 0; i < 2; ++i) { const int c = tid + i * NTHR, row = c >> 3, ch = c & 7; *(LAS pg8::u32x4*)(lds + B3_K + row * KPITCH + ch * 16) = kbuf[i]; }
#pragma unroll
        for (int i = 0; i < 4; ++i) { const int c = tid + i * NTHR, row = c >> 4, ch = c & 15; *(LAS pg8::u32x4*)(lds + B3_V + row * VPITCH + ch * 16) = vbuf[i]; }
#pragma unroll
        for (int i = 0; i < 4; ++i) { const int c = tid + i * NTHR, dir = c >> 10, cc = c & 1023, row = cc >> 4, ch = cc & 15;
            const f32x4 x0 = sbuf[i][0], x1 = sbuf[i][1];
            pg8::u32x4 a; a.x = pg8::cvt_pk_bf16(x0[0], x0[1]); a.y = pg8::cvt_pk_bf16(x0[2], x0[3]); a.z = pg8::cvt_pk_bf16(x1[0], x1[1]); a.w = pg8::cvt_pk_bf16(x1[2], x1[3]);
            *(LAS pg8::u32x4*)(lds + (dir ? B3_SB : B3_SF) + row * VPITCH + ch * 16) = a; }
    }
    __syncthreads();
    const int i = 16 * w + n, tokc = gn * 128 + i;
    const bf16* qp = Z + (size_t)tokc * NZ + 4608 + hb * 64;
    const int rsel = 4 * q + ((lane >> 2) & 3), csel = 8 * (lane & 3);
    f32x4 o[8];
    {
        const uint2 a0 = *(const uint2*)(qp + 4 * q), a1 = *(const uint2*)(qp + 16 + 4 * q), a2 = *(const uint2*)(qp + 32 + 4 * q), a3 = *(const uint2*)(qp + 48 + 4 * q);
        const bf16x8_t qc0 = __builtin_bit_cast(bf16x8_t, (uint4){a0.x, a0.y, a1.x, a1.y}), qc1 = __builtin_bit_cast(bf16x8_t, (uint4){a2.x, a2.y, a3.x, a3.y});
        const float cf = __expf(lgf * (float)(i + 1)), cb = __expf(lgb * (float)(128 - i));
#pragma unroll
        for (int et = 0; et < 8; ++et) {
            LAS unsigned char* sf = lds + B3_SF + rsel * VPITCH + et * 32 + csel;
            LAS unsigned char* sb = lds + B3_SB + rsel * VPITCH + et * 32 + csel;
            f32x4 f = {0.f, 0.f, 0.f, 0.f}, b = {0.f, 0.f, 0.f, 0.f};
            f = __builtin_amdgcn_mfma_f32_16x16x32_bf16(cat4(trread(sf), trread(sf + 16 * VPITCH)), qc0, f, 0, 0, 0);
            f = __builtin_amdgcn_mfma_f32_16x16x32_bf16(cat4(trread(sf + 32 * VPITCH), trread(sf + 48 * VPITCH)), qc1, f, 0, 0, 0);
            b = __builtin_amdgcn_mfma_f32_16x16x32_bf16(cat4(trread(sb), trread(sb + 16 * VPITCH)), qc0, b, 0, 0, 0);
            b = __builtin_amdgcn_mfma_f32_16x16x32_bf16(cat4(trread(sb + 32 * VPITCH), trread(sb + 48 * VPITCH)), qc1, b, 0, 0, 0);
            o[et] = f * cf + b * cb;
        }
    }
    {
        const bf16x8_t qf0 = *(const bf16x8_t*)(qp + 8 * q), qf1 = *(const bf16x8_t*)(qp + 32 + 8 * q);
        f32x4 s[8];
#pragma unroll
        for (int t = 0; t < 8; ++t) {
            LAS unsigned char* kp = lds + B3_K + (16 * t + n) * KPITCH + q * 16;
            f32x4 a = {0.f, 0.f, 0.f, 0.f};
            a = __builtin_amdgcn_mfma_f32_16x16x32_bf16(*(LAS bf16x8_t*)kp, qf0, a, 0, 0, 0);
            a = __builtin_amdgcn_mfma_f32_16x16x32_bf16(*(LAS bf16x8_t*)(kp + 64), qf1, a, 0, 0, 0);
#pragma unroll
            for (int j = 0; j < 4; ++j) { const int jj = 16 * t + 4 * q + j; const float dcy = (jj <= i) ? __expf(lgf * (float)(i - jj)) : __expf(lgb * (float)(jj - i)); a[j] = a[j] * 0.125f * dcy; }
            s[t] = a;
        }
#pragma unroll
        for (int G = 0; G < 4; ++G) {
            const bf16x8_t pb = packp(s[2 * G], s[2 * G + 1]);
#pragma unroll
            for (int et = 0; et < 8; ++et) {
                LAS unsigned char* vp = lds + B3_V + (32 * G + rsel) * VPITCH + et * 32 + csel;
                o[et] = __builtin_amdgcn_mfma_f32_16x16x32_bf16(cat4(trread(vp), trread(vp + 16 * VPITCH)), pb, o[et], 0, 0, 0);
            }
        }
    }
    float s1 = 0.f;
#pragma unroll
    for (int et = 0; et < 8; ++et) s1 += (o[et][0] + o[et][1]) + (o[et][2] + o[et][3]);
    s1 += __shfl_xor(s1, 16); s1 += __shfl_xor(s1, 32);
    const float mu = s1 * (1.f / 128.f);
    float s2 = 0.f;
#pragma unroll
    for (int et = 0; et < 8; ++et) { o[et] = o[et] - mu; s2 += (o[et][0] * o[et][0] + o[et][1] * o[et][1]) + (o[et][2] * o[et][2] + o[et][3] * o[et][3]); }
    s2 += __shfl_xor(s2, 16); s2 += __shfl_xor(s2, 32);
    const float rstd = 1.f / sqrtf(s2 * (1.f / 128.f) + GN_EPS);
    const bf16* gp = Z + (size_t)tokc * NZ + 5632 + hb * 128 + 4 * q;
    bf16* yp = Yb + (size_t)tokc * 512 + hb * 128 + 4 * q;
#pragma unroll
    for (int et = 0; et < 8; ++et) {
        const uint2 gw = *(const uint2*)(gp + et * 16);
        const float g0 = pg8::bflo(gw.x), g1 = pg8::bfhi(gw.x), g2 = pg8::bflo(gw.y), g3 = pg8::bfhi(gw.y);
        uint2 wv; wv.x = pg8::cvt_pk_bf16(o[et][0] * rstd * g0 * pg8::sigmoidf_(g0), o[et][1] * rstd * g1 * pg8::sigmoidf_(g1));
        wv.y = pg8::cvt_pk_bf16(o[et][2] * rstd * g2 * pg8::sigmoidf_(g2), o[et][3] * rstd * g3 * pg8::sigmoidf_(g3));
        *(uint2*)(yp + et * 16) = wv;
    }
}

#define RLX_AGENT __ATOMIC_RELAXED, __HIP_MEMORY_SCOPE_AGENT
#define XB_TMO      128
#define XB_XCNT(j)  (256  + 64 * (j))
#define XB_XSUB(j)  (1280 + 64 * (j))
#define XB_XGEN(j)  (2304 + 64 * (j))
#define XB_TOP      3328
#define XB_TOPGEN   3392
#define XCD_BAR_WORDS 3456
#define XB_SPIN_CAP (1u << 18)

__device__ __forceinline__ unsigned xb_ld(unsigned* p)              { return __hip_atomic_load(p, __ATOMIC_RELAXED, __HIP_MEMORY_SCOPE_AGENT); }
__device__ __forceinline__ unsigned xb_add(unsigned* p, unsigned v) { return __hip_atomic_fetch_add(p, v, __ATOMIC_RELAXED, __HIP_MEMORY_SCOPE_AGENT); }
__device__ __forceinline__ unsigned xb_xcc_id() { return (unsigned)__builtin_amdgcn_s_getreg((3 << 11) | 20) & 0xFu; }
#define XB_SPIN(cond, bar) do { unsigned _sp = 0; while (cond) { __builtin_amdgcn_s_sleep(1); \
    if ((++_sp & 255u) == 0u) { if (xb_ld(&(bar)[XB_TMO])) break; if (_sp > XB_SPIN_CAP) { atomicAdd(&(bar)[XB_TMO], 1u); break; } } } } while (0)

struct XcdBarrier {
    unsigned* bar; unsigned x;
    volatile LAS unsigned* st;
};

__device__ __forceinline__ XcdBarrier xcd_barrier_post(unsigned* bar, volatile LAS unsigned* st) {
    XcdBarrier b; b.bar = bar; b.x = xb_xcc_id(); b.st = st;
    if (threadIdx.x == 0) (void)xb_add(&bar[XB_XCNT(b.x)], 1u);
    return b;
}
__device__ __forceinline__ void xcd_barrier_complete(unsigned* bar, unsigned x, unsigned& nloc, unsigned& nx) {
    const unsigned G = gridDim.x * gridDim.y * gridDim.z;
    unsigned sum, cnt, mine, sp = 0u;
    for (;;) {
        sum = 0u; cnt = 0u; mine = 0u;
#pragma unroll
        for (unsigned j = 0; j < 16; ++j) { const unsigned c = xb_ld(&bar[XB_XCNT(j)]); sum += c; cnt += (c > 0u) ? 1u : 0u; mine = (j == x) ? c : mine; }
        if (sum == G) break;
        __builtin_amdgcn_s_sleep(1);
        if ((++sp & 255u) == 0u) { if (xb_ld(&bar[XB_TMO])) break; if (sp > XB_SPIN_CAP) { atomicAdd(&bar[XB_TMO], 1u); break; } }
    }
    nloc = mine > 0u ? mine : 1u; nx = cnt > 0u ? cnt : 1u;
}

__device__ __forceinline__ void xcd_barrier(const XcdBarrier& b) {
    asm volatile("s_waitcnt vmcnt(0)" ::: "memory");
    __syncthreads();
    if (threadIdx.x == 0) {
        unsigned* bar = b.bar;
        __builtin_amdgcn_s_waitcnt(0);
        unsigned nloc = b.st[0], nx = b.st[1];
        if (nloc == 0u) { xcd_barrier_complete(bar, b.x, nloc, nx); b.st[0] = nloc; b.st[1] = nx; }
        const unsigned old = xb_add(&bar[XB_XSUB(b.x)], 1u);
        const unsigned gen = old / nloc;
        if (old + 1u == (gen + 1u) * nloc) {
            __builtin_amdgcn_fence(__ATOMIC_RELEASE, "agent");
            asm volatile("s_waitcnt vmcnt(0)" ::: "memory");
            const unsigned og = xb_add(&bar[XB_TOP], 1u);
            const unsigned tg = og / nx;
            if (og + 1u == (tg + 1u) * nx) xb_add(&bar[XB_TOPGEN], 1u);
            else XB_SPIN(xb_ld(&bar[XB_TOPGEN]) == tg, bar);
            __builtin_amdgcn_fence(__ATOMIC_ACQUIRE, "agent");
            xb_add(&bar[XB_XGEN(b.x)], 1u);
            asm volatile("s_waitcnt vmcnt(0)" ::: "memory");
        } else {
            XB_SPIN(xb_ld(&bar[XB_XGEN(b.x)]) == gen, bar);
            __builtin_amdgcn_fence(__ATOMIC_ACQUIRE, "agent");
            asm volatile("s_waitcnt vmcnt(0)" ::: "memory");
        }
    }
    __syncthreads();
}

__device__ __forceinline__ float log_sigmoid_(float x) { return -log1pf(__expf(-x)); }
#ifndef PHMASK
#define PHMASK 0xFFFF
#endif
constexpr int NPHASE = 17;
__global__ void __launch_bounds__(NTHR, 2) fwd_megakernel(Params p) {
    extern __shared__ __attribute__((aligned(16))) unsigned char lds_raw[];
    cg::grid_group grid = cg::this_grid();
    LAS unsigned char* lds = (LAS unsigned char*)lds_raw;
    const int G = gridDim.x, bx = blockIdx.x;
    unsigned char* ws = p.ws;
    volatile LAS unsigned* bst = (volatile LAS unsigned*)(lds + 131072);
    if (threadIdx.x < 4) bst[threadIdx.x] = 0u;
    __syncthreads();
    if (ws == nullptr) grid.sync();
    const XcdBarrier xbar = xcd_barrier_post((unsigned*)ws, bst);

#pragma unroll 1
    for (int L = 0; L < DEPTH; ++L) {
        convert_weights(p, L, lds, G);
        xcd_barrier(xbar);
#pragma unroll 1
        for (int P = 0; P < 2; ++P) {
#pragma unroll 1
            for (int ph = 0; ph < NPHASE; ++ph) {
                const int sub = ph < 3 ? ph : (ph < 15 ? 3 + (ph - 3) % 6 : ph - 6);
                const int ci = (ph >= 9 && ph < 15) ? 1 : 0;
                bf16* WB = (bf16*)(ws + WS_W); bf16* XBp = (bf16*)(ws + WS_XB); bf16* XBc = XBp + (size_t)ci * MC * D;
                bf16* Zb = (bf16*)(ws + WS_Z); bf16* Hb = (bf16*)(ws + WS_Z); bf16* MG = (bf16*)(ws + WS_Z);
                float* PART = (float*)(ws + WS_PART); bf16* GT = (bf16*)(ws + WS_G); bf16* Y = (bf16*)(ws + WS_Y); float* ST = (float*)XBc; float* LSEb = (float*)(ws + WS_LSE);
                float* EXb = (float*)(ws + WS_Y);
                unsigned* CNT = (unsigned*)(ws + WS_CNT);
                float* Xp = p.out + (size_t)P * 2 * MC * D; float* Xc = Xp + (size_t)ci * MC * D;
                const float* xinp = p.in[P];
                const int S = (P == 0) ? 8192 : 16384, nseq = MC / S;
                const bool isgemm = (sub == 1 || sub == 2 || sub == 3 || sub == 7 || sub == 8 || sub == 9 || sub == 10);
                if (isgemm) {
                    pg8::Gemm g; pg8::Sched So;
                    typedef unsigned long long u64;
                    u64 ep[10]; int mode = 0;
#pragma unroll
                    for (int i = 0; i < 10; ++i) ep[i] = 0;
                    if (sub == 1 || sub == 9) { g = pg8::Gemm{XBp, WB + (sub == 1 ? WO_W1C : WO_W2C), 2 * MC, 2 * FF, D}; So.init(2 * MC, 2 * FF, 1, G, bx); mode = 0; ep[1] = (u64)Hb; }
                    else if (sub == 2) { g = pg8::Gemm{Hb, WB + WO_W1D, 2 * MC, D, FF}; So.init(2 * MC, D, 1, G, bx); mode = 1;
                        ep[1] = (u64)(L == 0 ? xinp : Xp); ep[2] = (u64)Xp; ep[3] = (u64)XBp; ep[4] = (u64)EXb; ep[5] = (u64)(p.in[5] + L * D); ep[6] = (u64)(p.in[6] + L * D); ep[7] = (u64)CNT;
                        ep[8] = (u64)__float_as_uint(ALPHA) | ((u64)__float_as_uint(0.5f) << 32); ep[9] = (u64)(unsigned)(4 * (3 * L + 1)) | ((u64)(unsigned)(P * 128) << 32); }
                    else if (sub == 10) { g = pg8::Gemm{Hb, WB + WO_W2D, 2 * MC, D, FF}; So.init(2 * MC, D, 1, G, bx); mode = 1;
                        ep[1] = (u64)Xp; ep[2] = (u64)Xp; ep[3] = (u64)XBp; ep[4] = (u64)EXb; ep[5] = (u64)(p.in[20] + L * D); ep[6] = (u64)(p.in[21] + L * D); ep[7] = (u64)CNT;
                        ep[8] = (u64)__float_as_uint(ALPHA) | ((u64)__float_as_uint(0.5f) << 32); ep[9] = (u64)(unsigned)(4 * (3 * L + 3)) | ((u64)(unsigned)(P * 128) << 32); }
                    else if (sub == 3) { g = pg8::Gemm{XBc, WB + WO_WIN, MC, DIN, D}; So.init(MC, DIN, 1, G, bx); mode = 2; ep[1] = (u64)Zb; ep[2] = (u64)GT; }
                    else if (sub == 7) { g = pg8::Gemm{Y, WB + WO_PBR, 3 * MC, 3 * D, 512}; So.init(MC, D, 3, G, bx); mode = 3; ep[1] = (u64)GT; ep[2] = (u64)PART; ep[3] = (u64)MG; }
                    else { g = pg8::Gemm{MG, WB + WO_WOUT, MC, D, D}; So.init(MC, D, 1, G, bx); mode = 1;
                        ep[1] = (u64)Xc; ep[2] = (u64)Xc; ep[3] = (u64)XBc; ep[4] = (u64)EXb; ep[5] = (u64)(p.in[15] + L * D); ep[6] = (u64)(p.in[16] + L * D); ep[7] = (u64)CNT;
                        ep[8] = (u64)__float_as_uint(ALPHA) | ((u64)__float_as_uint(1.0f) << 32); ep[9] = (u64)(unsigned)(4 * (3 * L + 2)) | ((u64)(unsigned)(P * 128 + ci * 64) << 32); }
                    ep[0] = (u64)(unsigned)mode;
                    if (threadIdx.x == 0) {
                        LAS u64* epl = (LAS u64*)(lds + 131072 + 64 + 2240);
#pragma unroll
                        for (int i = 0; i < 10; ++i) epl[i] = ep[i];
                    }
                    __syncthreads();
                    if (mode == 1) pg8::gemm_phase(lds, g, So, pg8::EpiAll<1>{}); else if (mode == 3) pg8::gemm_phase(lds, g, So, pg8::EpiAll<2>{}); else pg8::gemm_phase(lds, g, So, pg8::EpiAll<0>{});
                } else {
                    int tid = threadIdx.x; asm volatile("" : "+v"(tid));
                    const int gtid = bx * NTHR + tid, gthreads = G * NTHR;
                    if (sub == 0) {
                        convert_rows(L == 0 ? xinp : Xp, XBp, 2 * MC, gtid, gthreads);
                    } else if (sub == 4) {
                        constexpr int NB1 = 128 * 4, NA = 3 * 512, NC = 64 * 8;
                        const float* rpb = p.in[10] + L * 8 * 15 * 31;
                        int it = bx;
#pragma unroll 1
                        for (; it < NB1; it += G) { int t2 = tid; asm volatile("" : "+v"(t2)); const int gn = it >> 2, hb = it & 3;
                            mixB1_mfma_unit(Zb, ST, lds, gn, hb, log_sigmoid_(p.in[8][L * 4 + hb]), log_sigmoid_(p.in[9][L * 4 + hb]), t2); }
                        if (it < NB1 + NA) {
                            pg8::u32x4 abuf[A_NIT];
                            { int t2 = tid; asm volatile("" : "+v"(t2)); mixA_load(Zb, it - NB1, S, t2, abuf); }
#pragma unroll 1
                            for (; it < NB1 + NA; it += G) {
                                int t2 = tid; asm volatile("" : "+v"(t2));
                                __syncthreads(); mixA_store(lds, t2, abuf); __syncthreads();
                                if (it + G < NB1 + NA) mixA_load(Zb, it + G - NB1, S, t2, abuf);
                                mixA_compute(Zb, LSEb, lds, it - NB1, S, t2);
                            }
                        }
#pragma unroll 1
                        for (; it < NB1 + NA + NC; it += G) { int t2 = tid; asm volatile("" : "+v"(t2)); mixC_mfma_unit(Zb, Y + (size_t)2 * MC * 512, rpb, lds, it - NB1 - NA, S, t2); }
                    } else if (sub == 5) {
                        mixB2(ST, S, nseq, p.in[8] + L * 4, p.in[9] + L * 4, gtid, gthreads);
                    } else if (sub == 6) {
#pragma unroll 1
                        for (int it = bx; it < 128 * 4; it += G) { const int gn = it >> 2, hb = it & 3; int t2 = tid; asm volatile("" : "+v"(t2));
                            mixB3_mfma_unit(Zb, ST, Y + (size_t)MC * 512, lds, gn, hb, log_sigmoid_(p.in[8][L * 4 + hb]), log_sigmoid_(p.in[9][L * 4 + hb]), t2); }
                        mixA_merge(Zb, LSEb, Y, gtid, gthreads);
                    }
                }
                xcd_barrier(xbar);
            }
        }
    }
}

extern "C" void kernel_launch(void* const* d_in, const int* in_sizes, int n_in, void* d_out, int out_size, void* d_ws, size_t ws_size, hipStream_t stream) {
    static int grid = 0;
    if (grid == 0) {
        if (n_in != 22 || out_size != NTOK * D || ws_size < WS_END) { fprintf(stderr, "kernel_launch: unexpected shapes (n_in %d out %d ws %zu)\n", n_in, out_size, ws_size); grid = -1; return; }
        int dev = 0, cus = 0, per_cu = 0;
        hipGetDevice(&dev);
        hipDeviceGetAttribute(&cus, hipDeviceAttributeMultiprocessorCount, dev);
        hipFuncSetAttribute((const void*)fwd_megakernel, hipFuncAttributeMaxDynamicSharedMemorySize, LDS_BYTES);
        hipOccupancyMaxActiveBlocksPerMultiprocessor(&per_cu, (const void*)fwd_megakernel, NTHR, LDS_BYTES);
        if (per_cu < 1) { fprintf(stderr, "kernel_launch: occupancy query gives %d\n", per_cu); per_cu = 1; }
        (void)hipGetLastError();
        grid = cus * 1;
    }
    if (grid < 0) return;
    if (hipMemsetAsync(d_ws, 0, 32768, stream) != hipSuccess) { fprintf(stderr, "kernel_launch: memset of barrier words failed\n"); return; }
    Params p{};
    for (int i = 0; i < 22; ++i) p.in[i] = (const float*)d_in[i];
    p.out = (float*)d_out; p.ws = (unsigned char*)d_ws;
    void* args[] = {&p};
    hipError_t e = hipLaunchCooperativeKernel((const void*)fwd_megakernel, dim3(grid), dim3(NTHR), args, LDS_BYTES, stream);
    if (e != hipSuccess) fprintf(stderr, "cooperative launch failed: %s (grid %d)\n", hipGetErrorString(e), grid);
}
```

```cpp
#include <hip/hip_runtime.h>
#include <hip/hip_cooperative_groups.h>
#include <cstdio>
#include <cstdint>
namespace cg = cooperative_groups;

namespace pg8 {
#define PG8_LAS __attribute__((address_space(3)))
typedef unsigned short bf16_t;
typedef short bf16x8 __attribute__((ext_vector_type(8)));
typedef float f32x4 __attribute__((ext_vector_type(4)));
typedef unsigned u32x4 __attribute__((ext_vector_type(4)));
constexpr int BM = 256, BK = 64, HALF = 128, HTB = HALF * BK * 2, STAGE_BYTES = 8 * HTB, NXCD = 8, WGM = 8;

__host__ __device__ __forceinline__ int lds_byte(int r, int c) { const int st = (r >> 4) * 2 + (c >> 5), rr = r & 15, cc = c & 31, ob = rr * 64 + cc * 2; return st * 1024 + (ob ^ (((ob >> 9) & 1) << 5)); }
__host__ __device__ __forceinline__ void stage_rc(int b, int& R, int& C) { const int st = b / 1024, sb = b % 1024, swz = sb ^ (((sb >> 9) & 1) << 5); R = (st >> 1) * 16 + swz / 64; C = (st & 1) * 32 + (swz % 64) / 2; }
__host__ __device__ __forceinline__ int perm32(int rho) { const int n = rho >> 4, i = rho & 15; return 8 * (i >> 2) + 4 * n + (i & 3); }

struct Unit { int pm, pn; };
struct Gemm { const bf16_t* A; const bf16_t* Bt; int M, N, K; };

struct StaticOrder {
    int nM, nN, nwg, G, c, wgm;
    __host__ __device__ void init(int M, int N, int G_, int c_, int wgm_ = WGM) { nM = M / BM; nN = N / BM; nwg = nM * nN; G = G_; c = c_; wgm = wgm_; }
    __host__ __device__ bool next(int i, Unit& u) const {
        const long L = (long)i * G + c; if (L >= nwg) return false;
        int wgid = (int)L; { const int q = nwg / NXCD, r = nwg % NXCD, xcd = wgid % NXCD, off = wgid / NXCD; wgid = (xcd < r ? xcd * (q + 1) : r * (q + 1) + (xcd - r) * q) + off; }
        const int nig = wgm * nN, gid = wgid / nig, fm = gid * wgm, gsz = (nM - fm) < wgm ? (nM - fm) : wgm;
        u.pm = fm + ((wgid % nig) % gsz); u.pn = (wgid % nig) / gsz; return true;
    }
};
struct Sched {
    StaticOrder S0; int nbr, nMt, nNt;
    __device__ void init(int M, int N, int nbr_, int G_, int c_, int wgm_ = WGM) { S0.init(M, N, G_, c_, wgm_); nbr = nbr_; nMt = M / BM; nNt = N / BM; }
    __device__ bool next(int i, Unit& u) const {
        if (nbr == 1) return S0.next(i, u);
        Unit t; if (!S0.next(i / 3, t)) return false; const int b = i % 3; u.pm = b * nMt + t.pm; u.pn = b * nNt + t.pn; return true; }
    __device__ bool carry(int i) const { return nbr == 3 && (i % 3) != 2; }
};

__device__ __forceinline__ unsigned cvt_pk_bf16(float lo, float hi) { unsigned r; asm volatile("v_cvt_pk_bf16_f32 %0, %1, %2" : "=v"(r) : "v"(lo), "v"(hi)); return r; }
__device__ __forceinline__ float bflo(unsigned w) { return __uint_as_float(w << 16); }
__device__ __forceinline__ float bfhi(unsigned w) { return __uint_as_float(w & 0xffff0000u); }
__device__ __forceinline__ float sigmoidf_(float x) { return __builtin_amdgcn_rcpf(1.f + __expf(-x)); }

struct EpiSwiglu {
    static constexpr bool PERM = true;
    bf16_t* H; int ldh;
    __device__ __forceinline__ void operator()(const f32x4 (&acc)[2][2][4][2], const Unit& u, int wr, int wc, int fr, int fq) const {
        const int row0 = u.pm * BM + wr * 64 + fr, col0 = u.pn * HALF + wc * 32 + 8 * fq;
#pragma unroll
        for (int ai = 0; ai < 2; ++ai)
#pragma unroll
            for (int m = 0; m < 4; ++m) {
                f32x4 hv[2];
#pragma unroll
                for (int n = 0; n < 2; ++n) {
                    const f32x4 g = acc[ai][0][m][n], up = acc[ai][1][m][n];
                    const f32x4 t = g * (-1.44269504088896341f);
                    f32x4 d; d[0] = __builtin_amdgcn_exp2f(t[0]); d[1] = __builtin_amdgcn_exp2f(t[1]); d[2] = __builtin_amdgcn_exp2f(t[2]); d[3] = __builtin_amdgcn_exp2f(t[3]);
                    d = d + 1.0f;
                    f32x4 r; r[0] = __builtin_amdgcn_rcpf(d[0]); r[1] = __builtin_amdgcn_rcpf(d[1]); r[2] = __builtin_amdgcn_rcpf(d[2]); r[3] = __builtin_amdgcn_rcpf(d[3]);
                    hv[n] = (g * up) * r;
                }
                u32x4 w; w.x = cvt_pk_bf16(hv[0][0], hv[0][1]); w.y = cvt_pk_bf16(hv[0][2], hv[0][3]); w.z = cvt_pk_bf16(hv[1][0], hv[1][1]); w.w = cvt_pk_bf16(hv[1][2], hv[1][3]);
                *(u32x4*)(H + (size_t)(row0 + ai * HALF + m * 16) * ldh + col0) = w;
            }
    }
};
struct EpiResid {
    static constexpr bool PERM = true;
    const float* Xin; float* Xout; bf16_t* XB; float* EX; const float* gam; const float* bet; unsigned* cnt; unsigned target; int pbase; float alpha, s;
    __device__ __forceinline__ void operator()(f32x4 (&acc)[2][2][4][2], const Unit& u, int wr, int wc, int fr, int fq, PG8_LAS float* sl) const {
        const int tid = threadIdx.x;
        const int lr0 = wr * 64 + fr, col0 = u.pn * BM + wc * 32 + 8 * fq;
        PG8_LAS float* red = sl + 1008;
#pragma unroll
        for (int ai = 0; ai < 2; ++ai) {
            f32x4 xl[4][2][2];
#pragma unroll
            for (int m = 0; m < 4; ++m)
#pragma unroll
                for (int bj = 0; bj < 2; ++bj) {
                    const size_t off = (size_t)(u.pm * BM + lr0 + ai * HALF + m * 16) * 1024 + col0 + bj * HALF;
                    xl[m][bj][0] = *(const f32x4*)(Xin + off); xl[m][bj][1] = *(const f32x4*)(Xin + off + 4);
                }
#pragma unroll
            for (int m = 0; m < 4; ++m) {
                const int lr = lr0 + ai * HALF + m * 16;
                float rs = 0.f, rq = 0.f;
#pragma unroll
                for (int bj = 0; bj < 2; ++bj) {
                    const f32x4 x0 = xl[m][bj][0] * alpha + acc[ai][bj][m][0] * s, x1 = xl[m][bj][1] * alpha + acc[ai][bj][m][1] * s;
                    acc[ai][bj][m][0] = x0; acc[ai][bj][m][1] = x1;
                    rs += (x0[0] + x0[1]) + (x0[2] + x0[3]) + (x1[0] + x1[1]) + (x1[2] + x1[3]);
                    rq += (x0[0] * x0[0] + x0[1] * x0[1]) + (x0[2] * x0[2] + x0[3] * x0[3]) + (x1[0] * x1[0] + x1[1] * x1[1]) + (x1[2] * x1[2] + x1[3] * x1[3]);
                }
                rs += __shfl_xor(rs, 16); rs += __shfl_xor(rs, 32); rq += __shfl_xor(rq, 16); rq += __shfl_xor(rq, 32);
                if (fq == 0) { red[(wc * 256 + lr) * 2] = rs; red[(wc * 256 + lr) * 2 + 1] = rq; }
            }
            __builtin_amdgcn_sched_barrier(0);
        }
        asm volatile("s_waitcnt lgkmcnt(0)" ::: "memory"); __builtin_amdgcn_s_barrier();
        const int panel = pbase + u.pm;
        if (tid < 256) {
            float a = 0.f, b = 0.f;
#pragma unroll
            for (int k = 0; k < 4; ++k) { a += red[(k * 256 + tid) * 2]; b += red[(k * 256 + tid) * 2 + 1]; }
            float* ex = EX + ((size_t)(panel * 4 + u.pn) * 256 + tid) * 2;
            __hip_atomic_store(ex, a, __ATOMIC_RELAXED, __HIP_MEMORY_SCOPE_AGENT); __hip_atomic_store(ex + 1, b, __ATOMIC_RELAXED, __HIP_MEMORY_SCOPE_AGENT);
        }
        asm volatile("s_waitcnt vmcnt(0)" ::: "memory"); __builtin_amdgcn_s_barrier();
        if (tid == 0) {
            __hip_atomic_fetch_add(cnt + panel, 1u, __ATOMIC_RELAXED, __HIP_MEMORY_SCOPE_AGENT);
            unsigned sp = 0;
            while (__hip_atomic_load(cnt + panel, __ATOMIC_RELAXED, __HIP_MEMORY_SCOPE_AGENT) < target) { __builtin_amdgcn_s_sleep(1); if (++sp > (1u << 22)) break; }
        }
        __builtin_amdgcn_s_barrier();
        if (tid < 256) {
            float a = 0.f, b = 0.f;
#pragma unroll
            for (int k = 0; k < 4; ++k) { const float* ex = EX + ((size_t)(panel * 4 + k) * 256 + tid) * 2;
                a += __hip_atomic_load(ex, __ATOMIC_RELAXED, __HIP_MEMORY_SCOPE_AGENT); b += __hip_atomic_load(ex + 1, __ATOMIC_RELAXED, __HIP_MEMORY_SCOPE_AGENT); }
            const float mu = a * (1.f / 1024.f), var = fmaxf(b * (1.f / 1024.f) - mu * mu, 0.f);
            sl[2 * tid] = mu; sl[2 * tid + 1] = 1.f / sqrtf(var + 1e-5f);
        }
        asm volatile("s_waitcnt lgkmcnt(0)" ::: "memory"); __builtin_amdgcn_s_barrier();
#pragma unroll
        for (int bj = 0; bj < 2; ++bj) {
            const int col = col0 + bj * HALF;
            const f32x4 g0 = *(const f32x4*)(gam + col), g1 = *(const f32x4*)(gam + col + 4), b0 = *(const f32x4*)(bet + col), b1 = *(const f32x4*)(bet + col + 4);
#pragma unroll
            for (int ai = 0; ai < 2; ++ai)
#pragma unroll
                for (int m = 0; m < 4; ++m) {
                    const int lr = lr0 + ai * HALF + m * 16; const float mu = sl[2 * lr], rstd = sl[2 * lr + 1];
                    const size_t off = (size_t)(u.pm * BM + lr) * 1024 + col;
                    const f32x4 y0 = (acc[ai][bj][m][0] - mu) * rstd * g0 + b0, y1 = (acc[ai][bj][m][1] - mu) * rstd * g1 + b1;
                    *(f32x4*)(Xout + off) = y0; *(f32x4*)(Xout + off + 4) = y1;
                    u32x4 w; w.x = cvt_pk_bf16(y0[0], y0[1]); w.y = cvt_pk_bf16(y0[2], y0[3]); w.z = cvt_pk_bf16(y1[0], y1[1]); w.w = cvt_pk_bf16(y1[2], y1[3]);
                    *(u32x4*)(XB + off) = w;
                    __builtin_amdgcn_sched_barrier(0);
                }
        }
    }
};
struct EpiWin {
    static constexpr bool PERM = true;
    bf16_t* Z; bf16_t* Gt;
    __device__ __forceinline__ void operator()(const f32x4 (&acc)[2][2][4][2], const Unit& u, int wr, int wc, int fr, int fq) const {
        const int row0 = u.pm * BM + wr * 64 + fr; const bool isg = u.pn >= 30;
        bf16_t* base = isg ? Gt : Z; const int ld = isg ? 3072 : 7680; const int col0 = (isg ? (u.pn - 30) : u.pn) * BM + wc * 32 + 8 * fq;
#pragma unroll
        for (int ai = 0; ai < 2; ++ai)
#pragma unroll
            for (int m = 0; m < 4; ++m)
#pragma unroll
                for (int bj = 0; bj < 2; ++bj) {
                    f32x4 v0 = acc[ai][bj][m][0], v1 = acc[ai][bj][m][1];
                    if (isg) {
#pragma unroll
                        for (int j = 0; j < 4; ++j) { v0[j] = 1.f + __builtin_amdgcn_exp2f(v0[j] * -1.44269504088896341f); v1[j] = 1.f + __builtin_amdgcn_exp2f(v1[j] * -1.44269504088896341f); }
                    }
                    u32x4 w; w.x = cvt_pk_bf16(v0[0], v0[1]); w.y = cvt_pk_bf16(v0[2], v0[3]); w.z = cvt_pk_bf16(v1[0], v1[1]); w.w = cvt_pk_bf16(v1[2], v1[3]);
                    *(u32x4*)(base + (size_t)(row0 + ai * HALF + m * 16) * ld + col0 + bj * HALF) = w;
                }
    }
};
struct EpiBranch {
    static constexpr bool PERM = true;
    const bf16_t* Gt; bf16_t* Mg; int nMt;
    __device__ __forceinline__ void operator()(f32x4 (&acc)[2][2][4][2], const Unit& u, int wr, int wc, int fr, int fq) const {
        const int b = u.pm / nMt, pm = u.pm - b * nMt, pn = u.pn - b * 4;
        const int row0 = pm * BM + wr * 64 + fr, col0 = pn * BM + wc * 32 + 8 * fq;
#pragma unroll
        for (int ai = 0; ai < 2; ++ai) {
            u32x4 gw[4][2], gn[4][2];
#pragma unroll
            for (int m = 0; m < 4; ++m)
#pragma unroll
                for (int bj = 0; bj < 2; ++bj) {
                    const size_t row = (size_t)(row0 + ai * HALF + m * 16); const int col = col0 + bj * HALF;
                    gw[m][bj] = *(const u32x4*)(Gt + row * 3072 + b * 1024 + col);
                    if (b < 2) gn[m][bj] = *(const u32x4*)(Gt + row * 3072 + (b + 1) * 1024 + col); else gn[m][bj] = gw[m][bj];
                }
#pragma unroll
            for (int m = 0; m < 4; ++m)
#pragma unroll
                for (int bj = 0; bj < 2; ++bj) {
                    const u32x4 g = gw[m][bj], h = gn[m][bj];
                    f32x4 g0 = {bflo(g.x), bfhi(g.x), bflo(g.y), bfhi(g.y)}, g1 = {bflo(g.z), bfhi(g.z), bflo(g.w), bfhi(g.w)};
                    if (b < 2) {
                        const f32x4 h0 = {bflo(h.x), bfhi(h.x), bflo(h.y), bfhi(h.y)}, h1 = {bflo(h.z), bfhi(h.z), bflo(h.w), bfhi(h.w)};
#pragma unroll
                        for (int j = 0; j < 4; ++j) { g0[j] = h0[j] * __builtin_amdgcn_rcpf(g0[j]); g1[j] = h1[j] * __builtin_amdgcn_rcpf(g1[j]); }
                        acc[ai][bj][m][0] = acc[ai][bj][m][0] * g0; acc[ai][bj][m][1] = acc[ai][bj][m][1] * g1;
                    } else {
                        const size_t row = (size_t)(row0 + ai * HALF + m * 16); const int col = col0 + bj * HALF;
#pragma unroll
                        for (int j = 0; j < 4; ++j) { g0[j] = __builtin_amdgcn_rcpf(g0[j]); g1[j] = __builtin_amdgcn_rcpf(g1[j]); }
                        const f32x4 v0 = acc[ai][bj][m][0] * g0, v1 = acc[ai][bj][m][1] * g1;
                        u32x4 w; w.x = cvt_pk_bf16(v0[0], v0[1]); w.y = cvt_pk_bf16(v0[2], v0[3]); w.z = cvt_pk_bf16(v1[0], v1[1]); w.w = cvt_pk_bf16(v1[2], v1[3]);
                        *(u32x4*)(Mg + row * 1024 + col) = w;
                    }
                }
            __builtin_amdgcn_sched_barrier(0);
        }
    }
};

__device__ __forceinline__ unsigned long long ldsu64(PG8_LAS const unsigned long long* p) {
    const unsigned long long v = *p; const unsigned lo = __builtin_amdgcn_readfirstlane((unsigned)v), hi = __builtin_amdgcn_readfirstlane((unsigned)(v >> 32));
    return ((unsigned long long)hi << 32) | lo;
}
template <int KIND  > struct EpiAll {
    static constexpr bool PERM = true;
    __device__ __forceinline__ void operator()(f32x4 (&acc)[2][2][4][2], const Unit& u, int wr, int wc, int fr, int fq, PG8_LAS float* sl) const {
        asm volatile("" : "+v"(fr), "+v"(fq), "+s"(wr), "+s"(wc));
        PG8_LAS const unsigned long long* ep = (PG8_LAS const unsigned long long*)((PG8_LAS unsigned char*)sl + 2240);
        if constexpr (KIND == 1) { const unsigned long long as = ldsu64(ep + 8), tp = ldsu64(ep + 9);
            EpiResid e{(const float*)ldsu64(ep + 1), (float*)ldsu64(ep + 2), (bf16_t*)ldsu64(ep + 3), (float*)ldsu64(ep + 4), (const float*)ldsu64(ep + 5), (const float*)ldsu64(ep + 6),
                       (unsigned*)ldsu64(ep + 7), (unsigned)tp, (int)(unsigned)(tp >> 32), __uint_as_float((unsigned)as), __uint_as_float((unsigned)(as >> 32))}; e(acc, u, wr, wc, fr, fq, sl); }
        else if constexpr (KIND == 2) { EpiBranch e{(const bf16_t*)ldsu64(ep + 1), (bf16_t*)ldsu64(ep + 3), 64}; e(acc, u, wr, wc, fr, fq); }
        else {
            const unsigned long long s0 = ldsu64(ep); const int mode = (int)(unsigned)s0;
            if (mode == 0) { EpiSwiglu e{(bf16_t*)ldsu64(ep + 1), 2816}; e(acc, u, wr, wc, fr, fq); }
            else { EpiWin e{(bf16_t*)ldsu64(ep + 1), (bf16_t*)ldsu64(ep + 2)}; e(acc, u, wr, wc, fr, fq); }
        }
    }
};

template <class Epi, class Sched>
__device__ __forceinline__ void gemm_phase(PG8_LAS unsigned char* lds, const Gemm g, const Sched& S, const Epi& E) {
    int tid = threadIdx.x; asm volatile("" : "+v"(tid));
    const int wid = __builtin_amdgcn_readfirstlane(tid >> 6), lane = tid & 63, wr = wid >> 2, wc = wid & 3, fr = lane & 15, fq = lane >> 4;
    const int K = g.K, nt = K / BK;
    unsigned voffA[2], voffB[2];
#pragma unroll
    for (int i = 0; i < 2; ++i) { int R, C; stage_rc(tid * 16 + i * 8192, R, C); const int Rb = Epi::PERM ? ((R & ~31) + perm32(R & 31)) : R;
        voffA[i] = (unsigned)(R * K + C) * 2u; voffB[i] = (unsigned)(Rb * K + C) * 2u; }
    const size_t kstep = (size_t)(BK * 2);
    const size_t hstep = (size_t)HALF * K * 2;
    const size_t tstep = 2 * hstep;
    const unsigned ldsw = (unsigned)wid * 1024u;
    const int aoff = lds_byte(wr * 64 + fr, fq * 8), boff = lds_byte(wc * 32 + fr, fq * 8);
#define PG8_SA(b, h) (((b) * 2 + (h)) * HTB)
#define PG8_SB(b, h) ((4 + (b) * 2 + (h)) * HTB)
#define PG8_STAGE(bufoff, gbase, voff) do { _Pragma("unroll") for (int _i = 0; _i < 2; ++_i) \
        __builtin_amdgcn_global_load_lds((const unsigned*)((const char*)(gbase) + (voff)[_i]), (PG8_LAS unsigned*)(lds + (bufoff) + ldsw + _i * 8192), 16, 0, 0); } while (0)
#define PG8_LDA(dst, b, h) do { _Pragma("unroll") for (int m = 0; m < 4; ++m) _Pragma("unroll") for (int k = 0; k < 2; ++k) dst[m][k] = *(const PG8_LAS bf16x8*)(lds + PG8_SA(b, h) + aoff + m * 2048 + k * 1024); } while (0)
#define PG8_LDB(dst, b, h) do { _Pragma("unroll") for (int n = 0; n < 2; ++n) _Pragma("unroll") for (int k = 0; k < 2; ++k) dst[n][k] = *(const PG8_LAS bf16x8*)(lds + PG8_SB(b, h) + boff + n * 2048 + k * 1024); } while (0)
#define PG8_MMA(ai, bj, At, Bt) do { __builtin_amdgcn_s_setprio(1); _Pragma("unroll") for (int m = 0; m < 4; ++m) _Pragma("unroll") for (int n = 0; n < 2; ++n) _Pragma("unroll") for (int k = 0; k < 2; ++k) \
        acc[ai][bj][m][n] = __builtin_amdgcn_mfma_f32_16x16x32_bf16(Bt[n][k], At[m][k], acc[ai][bj][m][n], 0, 0, 0); __builtin_amdgcn_s_setprio(0); } while (0)
#define PG8_WAIT_V(n) asm volatile("s_waitcnt vmcnt(" #n ")" ::: "memory")
#define PG8_WAIT_L(n) asm volatile("s_waitcnt lgkmcnt(" #n ")" ::: "memory")
#define PG8_BAR __builtin_amdgcn_s_barrier()
#define PG8_SCHED __builtin_amdgcn_sched_barrier(0)
    Unit cur, nxt; int ui = 0;
    if (!S.next(0, cur)) return;
    f32x4 acc[2][2][4][2];
#pragma unroll
    for (int a = 0; a < 2; ++a)
#pragma unroll
        for (int b = 0; b < 2; ++b)
#pragma unroll
            for (int m = 0; m < 4; ++m)
#pragma unroll
                for (int n = 0; n < 2; ++n) acc[a][b][m][n] = (f32x4){0.f, 0.f, 0.f, 0.f};
    bf16x8 At[4][2], B0[2][2], B1[2][2];
    const char* cA = (const char*)g.A + (size_t)cur.pm * tstep; const char* cB = (const char*)g.Bt + (size_t)cur.pn * tstep;
    PG8_STAGE(PG8_SB(0, 0), cB, voffB); PG8_STAGE(PG8_SB(0, 1), cB + hstep, voffB); PG8_STAGE(PG8_SA(0, 0), cA, voffA); PG8_STAGE(PG8_SA(0, 1), cA + hstep, voffA);
    if (wr == 1) PG8_BAR;
    PG8_WAIT_V(2); PG8_BAR;
    PG8_STAGE(PG8_SB(1, 0), cB + kstep, voffB); PG8_STAGE(PG8_SA(1, 0), cA + kstep, voffA); PG8_STAGE(PG8_SB(1, 1), cB + hstep + kstep, voffB);
    PG8_WAIT_V(6); PG8_BAR;
    for (;;) {
        const bool has_next = S.next(ui + 1, nxt);
        const char* nA = has_next ? (const char*)g.A + (size_t)nxt.pm * tstep : cA; const char* nB = has_next ? (const char*)g.Bt + (size_t)nxt.pn * tstep : cB;
        for (int t = 0; t < nt; t += 2) {
            const bool last = (t == nt - 2);
            const char* a1 = cA + (size_t)(t + 1) * kstep;
            const char* a2 = last ? nA : cA + (size_t)(t + 2) * kstep; const char* b2 = last ? nB : cB + (size_t)(t + 2) * kstep;
            const char* a3 = a2 + kstep; const char* b3 = b2 + kstep;
            PG8_LDB(B0, 0, 0); PG8_LDB(B1, 0, 1); PG8_SCHED; PG8_LDA(At, 0, 0); PG8_STAGE(PG8_SA(1, 1), a1 + hstep, voffA);
            PG8_WAIT_V(8); PG8_WAIT_L(0); PG8_BAR; PG8_MMA(0, 0, At, B0); PG8_MMA(0, 1, At, B1); PG8_BAR; PG8_SCHED;
            PG8_LDA(At, 0, 1); PG8_STAGE(PG8_SB(0, 0), b2, voffB); PG8_STAGE(PG8_SB(0, 1), b2 + hstep, voffB); PG8_STAGE(PG8_SA(0, 0), a2, voffA);
            PG8_WAIT_V(8); PG8_WAIT_L(0); PG8_BAR; PG8_MMA(1, 0, At, B0); PG8_MMA(1, 1, At, B1); PG8_BAR; PG8_SCHED;
            PG8_LDB(B0, 1, 0); PG8_LDB(B1, 1, 1); PG8_SCHED; PG8_LDA(At, 1, 0); PG8_STAGE(PG8_SA(0, 1), a2 + hstep, voffA);
            PG8_WAIT_V(8); PG8_WAIT_L(0); PG8_BAR; PG8_MMA(0, 0, At, B0); PG8_MMA(0, 1, At, B1); PG8_BAR; PG8_SCHED;
            PG8_LDA(At, 1, 1); PG8_STAGE(PG8_SB(1, 0), b3, voffB); PG8_STAGE(PG8_SB(1, 1), b3 + hstep, voffB); PG8_STAGE(PG8_SA(1, 0), a3, voffA);
            PG8_WAIT_V(8); PG8_WAIT_L(0); PG8_BAR; PG8_MMA(1, 0, At, B0); PG8_MMA(1, 1, At, B1); PG8_BAR; PG8_SCHED;
        }
        if (wr == 0) PG8_BAR;
        E(acc, cur, wr, wc, fr, fq, (PG8_LAS float*)(lds + 131072 + 64));
        if (!has_next) break;
        if (!S.carry(ui))
#pragma unroll
        for (int a = 0; a < 2; ++a)
#pragma unroll
            for (int b = 0; b < 2; ++b)
#pragma unroll
                for (int m = 0; m < 4; ++m)
#pragma unroll
                    for (int n = 0; n < 2; ++n) acc[a][b][m][n] = (f32x4){0.f, 0.f, 0.f, 0.f};
        cur = nxt; cA = nA; cB = nB; ++ui;
        if (wr == 1) PG8_BAR;
    }
    PG8_WAIT_V(0);
    PG8_BAR;
#undef PG8_SA
#undef PG8_SB
#undef PG8_STAGE
#undef PG8_LDA
#undef PG8_LDB
#undef PG8_MMA
#undef PG8_WAIT_V
#undef PG8_WAIT_L
#undef PG8_BAR
#undef PG8_SCHED
}
}

typedef unsigned short bf16;
typedef float f32x4 __attribute__((ext_vector_type(4)));
#define LAS __attribute__((address_space(3)))
constexpr int D = 1024, FF = 2816, NZ = 7680, NGATE = 3072, DIN = 10752;
constexpr int NTOK = 65536, MC = 16384, NCHUNK = 4, DEPTH = 2;
constexpr int NWAVES = 8, NTHR = 512;
constexpr float ALPHA = 1.41421356237309515f;
constexpr float LN_EPS = 1e-5f, GN_EPS = 1e-5f;
constexpr size_t MiB = 1u << 20;
constexpr size_t WO_W1C = 0, WO_W1D = WO_W1C + (size_t)2 * FF * D, WO_WIN = WO_W1D + (size_t)D * FF, WO_PBR = WO_WIN + (size_t)DIN * D,
                 WO_WOUT = WO_PBR + (size_t)3 * D * 512, WO_W2C = WO_WOUT + (size_t)D * D, WO_W2D = WO_W2C + (size_t)2 * FF * D, WO_END = WO_W2D + (size_t)D * FF;
constexpr size_t WS_CNT = 16384;
constexpr size_t WS_W = 1 * MiB, WS_XB = 61 * MiB  , WS_Z = 125 * MiB, WS_PART = 157 * MiB, WS_G = 365 * MiB, WS_Y = 461 * MiB, WS_LSE = 509 * MiB, WS_END = 511 * MiB;
static_assert(WS_W + WO_END * 2 <= WS_XB && WS_XB + (size_t)2 * MC * D * 2 <= WS_Z, "weights / Xb fit");
static_assert(WS_Z + (size_t)MC * NZ * 2 <= WS_G && WS_Z + (size_t)2 * MC * FF * 2 <= WS_G && WS_PART + (size_t)MC * D * 4 <= WS_G && WS_Z + (size_t)MC * D * 2 <= WS_PART, "Z overlays (H of a pair, merged, partial)");
static_assert(WS_G + (size_t)MC * NGATE * 2 <= WS_Y && WS_Y + (size_t)3 * MC * 512 * 2 <= WS_LSE && (size_t)2 * 4 * 128 * 8192 * 4 <= (size_t)MC * D * 2 && WS_LSE + (size_t)3 * MC * 8 * 4 <= WS_END, "ws map");
constexpr int LDS_BYTES = 131072 + 16384;

struct Params { const float* in[22]; float* out; unsigned char* ws; };

__device__ __forceinline__ float bf2f(bf16 v) { return __uint_as_float(((unsigned)v) << 16); }
__device__ __forceinline__ unsigned f2bf(float f) { unsigned u = __builtin_bit_cast(unsigned, f); return (u + 0x7fffu + ((u >> 16) & 1u)) >> 16; }
__device__ __forceinline__ unsigned pk2(float lo, float hi) { return f2bf(lo) | (f2bf(hi) << 16); }
__device__ __forceinline__ void unpack8(const uint4 w, float* f) {
    f[0] = pg8::bflo(w.x); f[1] = pg8::bfhi(w.x); f[2] = pg8::bflo(w.y); f[3] = pg8::bfhi(w.y);
    f[4] = pg8::bflo(w.z); f[5] = pg8::bfhi(w.z); f[6] = pg8::bflo(w.w); f[7] = pg8::bfhi(w.w);
}
__device__ __forceinline__ float wave_sum(float v) {
#pragma unroll
    for (int o = 1; o < 64; o <<= 1) v += __shfl_xor(v, o);
    return v;
}

__device__ __forceinline__ void transpose_item(const float* W, int K, int N, bf16* WT, int kb, int n0, int row_base, LAS float* scr, int lane, const float* gvec) {
    const int k0 = 64 * kb;
#pragma unroll 8
    for (int i = 0; i < 32; ++i) { const int kk = 2 * i + (lane >> 5); scr[kk * 33 + (lane & 31)] = W[(size_t)(k0 + kk) * N + n0 + (lane & 31)]; }
    asm volatile("s_waitcnt lgkmcnt(0)" ::: "memory");
    const int c = lane & 7;
#pragma unroll
    for (int j = 0; j < 4; ++j) { const int n = (lane >> 3) + 8 * j; const LAS float* s = scr + (8 * c) * 33 + n;
        uint4 o; o.x = pk2(s[0 * 33], s[1 * 33]); o.y = pk2(s[2 * 33], s[3 * 33]); o.z = pk2(s[4 * 33], s[5 * 33]); o.w = pk2(s[6 * 33], s[7 * 33]);
        *(uint4*)(WT + (size_t)(row_base + n) * K + k0 + 8 * c) = o; }
    asm volatile("s_waitcnt lgkmcnt(0)" ::: "memory");
}
__device__ __forceinline__ void convert_weights(const Params& p, int L, LAS unsigned char* lds, int G) {
    int tid = threadIdx.x; asm volatile("" : "+v"(tid));
    const int lane = tid & 63, wave = __builtin_amdgcn_readfirstlane(tid >> 6);
    const int gw = blockIdx.x * NWAVES + wave, NGW = G * NWAVES;
    LAS float* scr = (LAS float*)(lds + wave * 16384);
    bf16* WB = (bf16*)(p.ws + WS_W);
    constexpr int I_UP = (D / 64) * (FF / 32), I_DN = (FF / 64) * (D / 32), I_IN = (D / 64) * (DIN / 32), I_BR = (512 / 64) * (D / 32), I_OUT = (D / 64) * (D / 32);
    constexpr int NITEMS = 4 * I_UP + 2 * I_DN + I_IN + 3 * I_BR + I_OUT;
#pragma unroll 1
    for (int it = gw; it < NITEMS; it += NGW) {
        int r = it; const float* W; int K, N, mode = 0, row_off = 0; size_t wo; const float* gv = nullptr;
        const float* gin1 = L ? p.in[20] + (size_t)(L - 1) * D : nullptr;
        if (r < I_UP) { W = p.in[2] + (size_t)L * D * FF; K = D; N = FF; mode = 1; wo = WO_W1C; }
        else if ((r -= I_UP) < I_UP) { W = p.in[3] + (size_t)L * D * FF; K = D; N = FF; mode = 2; wo = WO_W1C; }
        else if ((r -= I_UP) < I_DN) { W = p.in[4] + (size_t)L * FF * D; K = FF; N = D; wo = WO_W1D; }
        else if ((r -= I_DN) < I_IN) { W = p.in[7] + (size_t)L * D * DIN; K = D; N = DIN; wo = WO_WIN; }
        else if ((r -= I_IN) < I_BR) { W = p.in[11] + (size_t)L * 512 * D; K = 512; N = D; wo = WO_PBR; }
        else if ((r -= I_BR) < I_BR) { W = p.in[12] + (size_t)L * 512 * D; K = 512; N = D; wo = WO_PBR; row_off = 1024; }
        else if ((r -= I_BR) < I_BR) { W = p.in[13] + (size_t)L * 512 * D; K = 512; N = D; wo = WO_PBR; row_off = 2048; }
        else if ((r -= I_BR) < I_OUT) { W = p.in[14] + (size_t)L * D * D; K = D; N = D; wo = WO_WOUT; }
        else if ((r -= I_OUT) < I_UP) { W = p.in[17] + (size_t)L * D * FF; K = D; N = FF; mode = 1; wo = WO_W2C; }
        else if ((r -= I_UP) < I_UP) { W = p.in[18] + (size_t)L * D * FF; K = D; N = FF; mode = 2; wo = WO_W2C; }
        else { r -= I_UP; W = p.in[19] + (size_t)L * FF * D; K = FF; N = D; wo = WO_W2D; }
        const int nblk = N / 32, kb = r / nblk, n0 = (r % nblk) * 32;
        int row_base = row_off + n0;
        if (mode) row_base = (n0 >> 7) * 256 + (mode == 2 ? 128 : 0) + (n0 & 127);
        int ln = lane; asm volatile("" : "+v"(ln));
        transpose_item(W, K, N, WB + wo, kb, n0, row_base, scr, ln, gv);
    }
}

__device__ __forceinline__ void convert_rows(const float* src, bf16* xb, int nrows, int gtid, int gthreads) {
    const int n4 = nrows * (D / 4);
    for (int i = gtid; i < n4; i += 4 * gthreads) {
        f32x4 v[4];
#pragma unroll
        for (int k = 0; k < 4; ++k) { const int j = i + k * gthreads; if (j < n4) v[k] = __builtin_nontemporal_load((const f32x4*)src + j); }
#pragma unroll
        for (int k = 0; k < 4; ++k) { const int j = i + k * gthreads; if (j < n4) { uint2 o; o.x = pk2(v[k].x, v[k].y); o.y = pk2(v[k].z, v[k].w); ((uint2*)xb)[j] = o; } }
    }
}
template <bool FINAL>
__device__ __forceinline__ void ln_pass(float* V, bf16* xb, float* RS, const float* g, const float* b, int nrows, int gw, int NGW, int lane) {
    f32x4 gv[4], bv[4];
#pragma unroll
    for (int j = 0; j < 4; ++j) { gv[j] = ((const f32x4*)g)[lane + 64 * j]; bv[j] = ((const f32x4*)b)[lane + 64 * j]; }
    for (int m = gw; m < nrows; m += NGW) {
        f32x4* xr = (f32x4*)(V + (size_t)m * D) + lane;
        f32x4 v[4]; float s = 0.f;
#pragma unroll
        for (int j = 0; j < 4; ++j) { v[j] = xr[64 * j]; s += (v[j].x + v[j].y) + (v[j].z + v[j].w); }
        const float mean = wave_sum(s) * (1.f / D); float s2 = 0.f;
#pragma unroll
        for (int j = 0; j < 4; ++j) { v[j] = v[j] - mean; s2 += (v[j].x * v[j].x + v[j].y * v[j].y) + (v[j].z * v[j].z + v[j].w * v[j].w); }
        const float rstd = 1.f / sqrtf(wave_sum(s2) * (1.f / D) + LN_EPS);
        if (FINAL) {
#pragma unroll
            for (int j = 0; j < 4; ++j) xr[64 * j] = v[j] * rstd * gv[j] + bv[j];
        } else {
            if (lane == 0) { float2 st; st.x = mean; st.y = rstd; *(float2*)(RS + (size_t)m * 2) = st; }
            uint2* o8 = (uint2*)(xb + (size_t)m * D) + lane;
#pragma unroll
            for (int j = 0; j < 4; ++j) { const f32x4 y = v[j] * rstd * gv[j] + bv[j]; uint2 o; o.x = pk2(y.x, y.y); o.y = pk2(y.z, y.w); o8[64 * j] = o; }
        }
    }
}

__device__ __forceinline__ void mixA_unit(const bf16* Z, bf16* Ya, int tc0, int S, int h, int tid) {
    const int ql = tid >> 3, sub = tid & 7;
    const int tc = tc0 + ql, seq0 = (tc / S) * S, t = tc - seq0;
    const bf16* zq = Z + (size_t)tc * NZ;
    const float slope = exp2f(-(float)(h + 1));
    float m = -1e30f, l = 0.f, o[8];
#pragma unroll
    for (int i = 0; i < 8; ++i) o[i] = 0.f;
#pragma unroll 1
    for (int g = 0; g < 3; ++g) {
        const int dil = 1 << (2 * g);
        float q[8]; unpack8(*(const uint4*)(zq + g * 512 + h * 64 + sub * 8), q);
#pragma unroll
        for (int i = 0; i < 8; ++i) q[i] *= 0.125f;
        const bf16* kbase = Z + (size_t)seq0 * NZ + 1536 + g * 512 + h * 64 + sub * 8;
#pragma unroll 1
        for (int jj = 0; jj <= 128; ++jj) {
            const int j = jj - 64, s = t + j * dil; const bool valid = (s >= 0) && (s < S); const int sc_ = valid ? s : t;
            const bf16* kp = kbase + (size_t)sc_ * NZ;
            float k[8], v[8]; unpack8(*(const uint4*)kp, k); unpack8(*(const uint4*)(kp + 1536), v);
            float dot = 0.f;
#pragma unroll
            for (int i = 0; i < 8; ++i) dot += q[i] * k[i];
            dot += __shfl_xor(dot, 1); dot += __shfl_xor(dot, 2); dot += __shfl_xor(dot, 4);
            const float sc = dot - slope * (float)((j < 0 ? -j : j) * dil);
            const float mn = valid ? fmaxf(m, sc) : m;
            const float corr = __expf(m - mn), pe = valid ? __expf(sc - mn) : 0.f;
            l = l * corr + pe;
#pragma unroll
            for (int i = 0; i < 8; ++i) o[i] = o[i] * corr + pe * v[i];
            m = mn;
        }
    }
    const float inv = 1.f / l;
    uint4 w; w.x = pk2(o[0] * inv, o[1] * inv); w.y = pk2(o[2] * inv, o[3] * inv); w.z = pk2(o[4] * inv, o[5] * inv); w.w = pk2(o[6] * inv, o[7] * inv);
    *(uint4*)(Ya + (size_t)tc * 512 + h * 64 + sub * 8) = w;
}
__device__ __forceinline__ void mixC_unit(const bf16* Z, bf16* Yc, const float* rpb, int tc0, int S, int h, int tid) {
    const int ql = tid >> 3, sub = tid & 7;
    const int tc = tc0 + ql, seq0 = (tc / S) * S, t = tc - seq0;
    const int rows = S / 64, qr = t >> 6, qc = t & 63;
    int rs = qr - 4; rs = rs < 0 ? 0 : (rs > rows - 8 ? rows - 8 : rs);
    int cs = qc - 8; cs = cs < 0 ? 0 : (cs > 48 ? 48 : cs);
    float q[8]; unpack8(*(const uint4*)(Z + (size_t)tc * NZ + 6144 + h * 64 + sub * 8), q);
#pragma unroll
    for (int i = 0; i < 8; ++i) q[i] *= 0.125f;
    const bf16* kbase = Z + (size_t)seq0 * NZ + 6656 + h * 64 + sub * 8;
    const float* rb = rpb + h * 15 * 31;
    float m = -1e30f, l = 0.f, o[8];
#pragma unroll
    for (int i = 0; i < 8; ++i) o[i] = 0.f;
#pragma unroll 2
    for (int kk = 0; kk < 128; ++kk) {
        const int kr = rs + (kk >> 4), kc = cs + (kk & 15), s = kr * 64 + kc;
        const bf16* kp = kbase + (size_t)s * NZ;
        float k[8], v[8]; unpack8(*(const uint4*)kp, k); unpack8(*(const uint4*)(kp + 512), v);
        float dot = 0.f;
#pragma unroll
        for (int i = 0; i < 8; ++i) dot += q[i] * k[i];
        dot += __shfl_xor(dot, 1); dot += __shfl_xor(dot, 2); dot += __shfl_xor(dot, 4);
        const float sc = dot + rb[(kr - qr + 7) * 31 + (kc - qc + 15)];
        const float mn = fmaxf(m, sc);
        const float corr = __expf(m - mn), pe = __expf(sc - mn);
        l = l * corr + pe;
#pragma unroll
        for (int i = 0; i < 8; ++i) o[i] = o[i] * corr + pe * v[i];
        m = mn;
    }
    const float inv = 1.f / l;
    uint4 w; w.x = pk2(o[0] * inv, o[1] * inv); w.y = pk2(o[2] * inv, o[3] * inv); w.z = pk2(o[4] * inv, o[5] * inv); w.w = pk2(o[6] * inv, o[7] * inv);
    *(uint4*)(Yc + (size_t)tc * 512 + h * 64 + sub * 8) = w;
}
__device__ __forceinline__ void mixB1_unit(const bf16* Z, float* ST, int gn, int hb, float lgf, float lgb, int tid) {
    const int d = tid >> 3, eb = (tid & 7) * 16;
    float f[16], b[16];
#pragma unroll
    for (int i = 0; i < 16; ++i) { f[i] = 0.f; b[i] = 0.f; }
    const bf16* zb = Z + (size_t)gn * 128 * NZ;
#pragma unroll 2
    for (int j = 0; j < 128; ++j) {
        const bf16* zr = zb + (size_t)j * NZ;
        const float kd = bf2f(zr[4864 + hb * 64 + d]) * 0.125f;
        float v[16]; unpack8(*(const uint4*)(zr + 5120 + hb * 128 + eb), v); unpack8(*(const uint4*)(zr + 5120 + hb * 128 + eb + 8), v + 8);
        const float wf = kd * __expf(lgf * (float)(127 - j)), wb = kd * __expf(lgb * (float)j);
#pragma unroll
        for (int i = 0; i < 16; ++i) { f[i] += wf * v[i]; b[i] += wb * v[i]; }
    }
    float* pf = ST + ((size_t)(0 * 4 + hb) * 128 + gn) * 8192 + d * 128 + eb;
    float* pb = ST + ((size_t)(1 * 4 + hb) * 128 + gn) * 8192 + d * 128 + eb;
#pragma unroll
    for (int i = 0; i < 4; ++i) { ((f32x4*)pf)[i] = (f32x4){f[4 * i], f[4 * i + 1], f[4 * i + 2], f[4 * i + 3]}; ((f32x4*)pb)[i] = (f32x4){b[4 * i], b[4 * i + 1], b[4 * i + 2], b[4 * i + 3]}; }
}
__device__ __forceinline__ float log_sigmoid2_(float x) { return -log1pf(__expf(-x)); }
__device__ __forceinline__ void mixB2(float* ST, int S, int nseq, const float* lgf4, const float* lgb4, int gtid, int gthreads) {
    const int N = S / 128, total = 2 * 4 * nseq * 8192;
    for (int id = gtid; id < total; id += gthreads) {
        const int el = id & 8191; int r = id >> 13; const int sq = r % nseq; r /= nseq; const int hb = r & 3, dir = r >> 2;
        const float lg = log_sigmoid2_(dir ? lgb4[hb] : lgf4[hb]); const float decay = __expf(lg * 128.f);
        float* p = ST + ((size_t)(dir * 4 + hb) * 128 + sq * N) * 8192 + el;
        float s = 0.f;
        for (int n0 = 0; n0 < N; n0 += 8) {
            float tmp[8];
#pragma unroll
            for (int i = 0; i < 8; ++i) { const int n = dir ? (N - 1 - (n0 + i)) : (n0 + i); tmp[i] = p[(size_t)n * 8192]; }
#pragma unroll
            for (int i = 0; i < 8; ++i) { const int n = dir ? (N - 1 - (n0 + i)) : (n0 + i); p[(size_t)n * 8192] = s; s = decay * s + tmp[i]; }
        }
    }
}
__device__ __forceinline__ void mixB3_unit(const bf16* Z, const float* ST, bf16* Yb, int gn, int hb, float lgf, float lgb, int tid) {
    const int i = tid >> 2, sub = tid & 3;
    const int tc = gn * 128 + i;
    const bf16* zq = Z + (size_t)tc * NZ;
    float q[64];
#pragma unroll
    for (int c = 0; c < 8; ++c) unpack8(*(const uint4*)(zq + 4608 + hb * 64 + c * 8), q + c * 8);
    float o[32];
#pragma unroll
    for (int e = 0; e < 32; ++e) o[e] = 0.f;
    const bf16* zb = Z + (size_t)gn * 128 * NZ;
#pragma unroll 1
    for (int j = 0; j < 128; ++j) {
        const bf16* zr = zb + (size_t)j * NZ;
        float dot = 0.f;
#pragma unroll
        for (int c = 0; c < 8; ++c) { float k[8]; unpack8(*(const uint4*)(zr + 4864 + hb * 64 + c * 8), k);
#pragma unroll
            for (int x = 0; x < 8; ++x) dot += q[c * 8 + x] * k[x]; }
        const float w = dot * 0.125f * (j <= i ? __expf(lgf * (float)(i - j)) : __expf(lgb * (float)(j - i)));
#pragma unroll
        for (int c = 0; c < 4; ++c) { float v[8]; unpack8(*(const uint4*)(zr + 5120 + hb * 128 + sub * 32 + c * 8), v);
#pragma unroll
            for (int x = 0; x < 8; ++x) o[c * 8 + x] += w * v[x]; }
    }
    const float cf = __expf(lgf * (float)(i + 1)), cb = __expf(lgb * (float)(128 - i));
    const float* Sf = ST + ((size_t)(0 * 4 + hb) * 128 + gn) * 8192 + sub * 32;
    const float* Sb = ST + ((size_t)(1 * 4 + hb) * 128 + gn) * 8192 + sub * 32;
#pragma unroll 2
    for (int d = 0; d < 64; ++d) {
        const float qd = bf2f(zq[4608 + hb * 64 + d]); const float a = qd * cf, b = qd * cb;
#pragma unroll
        for (int c = 0; c < 8; ++c) { const f32x4 sf = ((const f32x4*)(Sf + d * 128))[c], sb = ((const f32x4*)(Sb + d * 128))[c];
            o[4 * c] += a * sf.x + b * sb.x; o[4 * c + 1] += a * sf.y + b * sb.y; o[4 * c + 2] += a * sf.z + b * sb.z; o[4 * c + 3] += a * sf.w + b * sb.w; }
    }
    float s1 = 0.f;
#pragma unroll
    for (int e = 0; e < 32; ++e) s1 += o[e];
    s1 += __shfl_xor(s1, 1); s1 += __shfl_xor(s1, 2);
    const float mu = s1 * (1.f / 128.f);
    float s2 = 0.f;
#pragma unroll
    for (int e = 0; e < 32; ++e) { o[e] -= mu; s2 += o[e] * o[e]; }
    s2 += __shfl_xor(s2, 1); s2 += __shfl_xor(s2, 2);
    const float rstd = 1.f / sqrtf(s2 * (1.f / 128.f) + GN_EPS);
#pragma unroll
    for (int c = 0; c < 4; ++c) {
        float gt[8]; unpack8(*(const uint4*)(zq + 5632 + hb * 128 + sub * 32 + c * 8), gt);
        float y[8];
#pragma unroll
        for (int x = 0; x < 8; ++x) y[x] = o[c * 8 + x] * rstd * gt[x] * pg8::sigmoidf_(gt[x]);
        uint4 w; w.x = pk2(y[0], y[1]); w.y = pk2(y[2], y[3]); w.z = pk2(y[4], y[5]); w.w = pk2(y[6], y[7]);
        *(uint4*)(Yb + (size_t)tc * 512 + hb * 128 + sub * 32 + c * 8) = w;
    }
}

typedef short bf16x8_t __attribute__((ext_vector_type(8)));
typedef short s16x4_t __attribute__((ext_vector_type(4)));
__device__ __forceinline__ s16x4_t trread(LAS unsigned char* p) { return __builtin_amdgcn_ds_read_tr16_b64_v4i16((LAS s16x4_t*)p); }
__device__ __forceinline__ bf16x8_t cat4(s16x4_t a, s16x4_t b) { return (bf16x8_t){a[0], a[1], a[2], a[3], b[0], b[1], b[2], b[3]}; }
__device__ __forceinline__ bf16x8_t packp(f32x4 a, f32x4 b) {
    uint4 w; w.x = pg8::cvt_pk_bf16(a[0], a[1]); w.y = pg8::cvt_pk_bf16(a[2], a[3]); w.z = pg8::cvt_pk_bf16(b[0], b[1]); w.w = pg8::cvt_pk_bf16(b[2], b[3]);
    return __builtin_bit_cast(bf16x8_t, w);
}
constexpr int KPITCH = 144;
constexpr int A_ROWS = 400, A_VOFF = A_ROWS * KPITCH;
constexpr int A_TOT = 2 * A_ROWS * 8, A_NIT = (A_TOT + NTHR - 1) / NTHR;
__device__ __forceinline__ void mixA_load(const bf16* Z, int u, int S, int tid, pg8::u32x4 (&buf)[A_NIT]) {
    const int g = u >> 9, h = u & 7, tt = (u >> 3) & 63;
    const int dil = 1 << (2 * g), Lg = S / dil, tps = S >> 8, tpr = Lg >> 8;
    const int sq = tt / tps, x = tt - sq * tps, r = x / tpr, i0 = (x - r * tpr) << 8;
    const bf16* zk = Z + (size_t)(sq * S) * NZ + 1536 + g * 512 + h * 64;
#pragma unroll
    for (int i = 0; i < A_NIT; ++i) {
        const int c = tid + i * NTHR; const int mat = c >= A_ROWS * 8, cc = c - mat * A_ROWS * 8, row = cc >> 3, ch = cc & 7, idx = i0 - 64 + row;
        buf[i] = (pg8::u32x4){0u, 0u, 0u, 0u};
        if (c < A_TOT && idx >= 0 && idx < Lg) buf[i] = *(const pg8::u32x4*)(zk + (size_t)(idx * dil + r) * NZ + mat * 1536 + ch * 8);
    }
}
__device__ __forceinline__ void mixA_store(LAS unsigned char* lds, int tid, const pg8::u32x4 (&buf)[A_NIT]) {
#pragma unroll
    for (int i = 0; i < A_NIT; ++i) {
        const int c = tid + i * NTHR; const int mat = c >= A_ROWS * 8, cc = c - mat * A_ROWS * 8, row = cc >> 3, ch = cc & 7;
        if (c < A_TOT) *(LAS pg8::u32x4*)(lds + mat * A_VOFF + row * KPITCH + ch * 16) = buf[i];
    }
}
__device__ __forceinline__ void mixA_compute(bf16* Z, float* LSE, LAS unsigned char* lds, int u, int S, int tid) {
    const int g = u >> 9, h = u & 7, tt = (u >> 3) & 63;
    const int dil = 1 << (2 * g), Lg = S / dil, tps = S >> 8, tpr = Lg >> 8;
    const int sq = tt / tps, x = tt - sq * tps, r = x / tpr, i0 = (x - r * tpr) << 8;
    const int seq0 = sq * S;
    const int lane = tid & 63, w = tid >> 6, n = lane & 15, q = lane >> 4;
#pragma unroll
    for (int qt = 0; qt < 2; ++qt) {
    const int wt = 2 * w + qt;
    const int iq = i0 + 16 * wt + n, tokc = seq0 + iq * dil + r;
    bf16* qp = Z + (size_t)tokc * NZ + g * 512 + h * 64;
    const bf16x8_t qf0 = *(const bf16x8_t*)(qp + 8 * q), qf1 = *(const bf16x8_t*)(qp + 32 + 8 * q);
    f32x4 s[10];
#pragma unroll
    for (int t = 0; t < 9; ++t) {
        LAS unsigned char* kp = lds + (16 * wt + 16 * t + n) * KPITCH + q * 16;
        const bf16x8_t kf0 = *(LAS bf16x8_t*)kp, kf1 = *(LAS bf16x8_t*)(kp + 64);
        f32x4 a = {0.f, 0.f, 0.f, 0.f};
        a = __builtin_amdgcn_mfma_f32_16x16x32_bf16(kf0, qf0, a, 0, 0, 0);
        s[t] = __builtin_amdgcn_mfma_f32_16x16x32_bf16(kf1, qf1, a, 0, 0, 0);
    }
    s[9] = (f32x4){0.f, 0.f, 0.f, 0.f};
    const float slope = exp2f(-(float)(h + 1)) * (float)dil;
    float m = -1e30f;
#pragma unroll
    for (int t = 0; t < 9; ++t)
#pragma unroll
        for (int j = 0; j < 4; ++j) {
            const int rel = 16 * t + 4 * q + j - 64 - n, idxk = i0 - 64 + 16 * wt + 16 * t + 4 * q + j;
            const bool valid = (rel >= -64) && (rel <= 64) && (idxk >= 0) && (idxk < Lg);
            const float sc = s[t][j] * 0.125f - slope * (float)(rel < 0 ? -rel : rel);
            s[t][j] = valid ? sc : -1e30f; m = fmaxf(m, s[t][j]);
        }
    m = fmaxf(m, __shfl_xor(m, 16)); m = fmaxf(m, __shfl_xor(m, 32));
    float l = 0.f;
#pragma unroll
    for (int t = 0; t < 9; ++t)
#pragma unroll
        for (int j = 0; j < 4; ++j) { const float pe = __expf(s[t][j] - m); s[t][j] = pe; l += pe; }
    l += __shfl_xor(l, 16); l += __shfl_xor(l, 32);
    f32x4 o[4];
#pragma unroll
    for (int dt = 0; dt < 4; ++dt) o[dt] = (f32x4){0.f, 0.f, 0.f, 0.f};
    LAS unsigned char* vb = lds + A_VOFF + (16 * wt + 4 * q + ((lane >> 2) & 3)) * KPITCH + 8 * (lane & 3);
#pragma unroll
    for (int G = 0; G < 5; ++G) {
        const bf16x8_t pb = packp(s[2 * G], s[2 * G + 1]);
#pragma unroll
        for (int dt = 0; dt < 4; ++dt) {
            const s16x4_t lo = trread(vb + (32 * G) * KPITCH + dt * 32), hi = trread(vb + (32 * G + 16) * KPITCH + dt * 32);
            o[dt] = __builtin_amdgcn_mfma_f32_16x16x32_bf16(cat4(lo, hi), pb, o[dt], 0, 0, 0);
        }
    }
    const float inv = 1.f / l;
#pragma unroll
    for (int dt = 0; dt < 4; ++dt) { uint2 wv; wv.x = pg8::cvt_pk_bf16(o[dt][0] * inv, o[dt][1] * inv); wv.y = pg8::cvt_pk_bf16(o[dt][2] * inv, o[dt][3] * inv);
        *(uint2*)(qp + dt * 16 + 4 * q) = wv; }
    if (q == 0) LSE[((size_t)g * MC + tokc) * 8 + h] = m + __logf(l);
    }
}
__device__ __forceinline__ void mixA_merge(const bf16* Z, const float* LSE, bf16* Ya, int gtid, int gthreads) {
    for (int it = gtid; it < MC * 64; it += gthreads) {
        const int tok = it >> 6, h = (it >> 3) & 7, ch = it & 7;
        const float l0 = LSE[((size_t)0 * MC + tok) * 8 + h], l1 = LSE[((size_t)1 * MC + tok) * 8 + h], l2 = LSE[((size_t)2 * MC + tok) * 8 + h];
        const float mx = fmaxf(l0, fmaxf(l1, l2));
        float w0 = __expf(l0 - mx), w1 = __expf(l1 - mx), w2 = __expf(l2 - mx); const float inv = 1.f / (w0 + w1 + w2); w0 *= inv; w1 *= inv; w2 *= inv;
        const bf16* zp = Z + (size_t)tok * NZ + h * 64 + ch * 8;
        float a[8], b[8], c[8]; unpack8(*(const uint4*)zp, a); unpack8(*(const uint4*)(zp + 512), b); unpack8(*(const uint4*)(zp + 1024), c);
        uint4 wv; wv.x = pk2(w0 * a[0] + w1 * b[0] + w2 * c[0], w0 * a[1] + w1 * b[1] + w2 * c[1]); wv.y = pk2(w0 * a[2] + w1 * b[2] + w2 * c[2], w0 * a[3] + w1 * b[3] + w2 * c[3]);
        wv.z = pk2(w0 * a[4] + w1 * b[4] + w2 * c[4], w0 * a[5] + w1 * b[5] + w2 * c[5]); wv.w = pk2(w0 * a[6] + w1 * b[6] + w2 * c[6], w0 * a[7] + w1 * b[7] + w2 * c[7]);
        *(uint4*)(Ya + (size_t)tok * 512 + h * 64 + ch * 8) = wv;
    }
}
constexpr int C_ROWS = 704;
__device__ __forceinline__ void mixC_mfma_unit(const bf16* Z, bf16* Yc, const float* rpb, LAS unsigned char* lds, int u, int S, int tid) {
    const int h = u & 7, rp = u >> 3, rps = S >> 8, sq = rp / rps, np = rp - sq * rps, seq0 = sq * S, rows = S >> 6;
    const int lane = tid & 63, w = tid >> 6, n = lane & 15, q = lane >> 4;
    int rb = 4 * np - 4; rb = rb < 0 ? 0 : (rb > rows - 11 ? rows - 11 : rb);
    const bf16* zk = Z + (size_t)seq0 * NZ + 6656 + h * 64;
    __syncthreads();
    {
        constexpr int NIT = C_ROWS * 8 / NTHR;
        pg8::u32x4 buf[NIT];
#pragma unroll
        for (int i = 0; i < NIT; ++i) { const int c = tid + i * NTHR, row = c >> 3, ch = c & 7; buf[i] = *(const pg8::u32x4*)(zk + (size_t)(rb * 64 + row) * NZ + 512 + ch * 8); }
#pragma unroll
        for (int i = 0; i < NIT; ++i) { const int c = tid + i * NTHR, row = c >> 3, ch = c & 7; *(LAS pg8::u32x4*)(lds + row * KPITCH + ch * 16) = buf[i]; }
        if (tid < 15 * 31) ((LAS float*)(lds + C_ROWS * KPITCH))[tid] = rpb[h * 15 * 31 + tid];
    }
    __syncthreads();
#pragma unroll
    for (int qt = 0; qt < 2; ++qt) {
    const int qr = 4 * np + 2 * qt + (w >> 2), cb = w & 3, qc = cb * 16 + n;
    int rs = qr - 4; rs = rs < 0 ? 0 : (rs > rows - 8 ? rows - 8 : rs);
    int cbs = cb * 16 - 8; cbs = cbs < 0 ? 0 : (cbs > 32 ? 32 : cbs);
    int cs = qc - 8; cs = cs < 0 ? 0 : (cs > 48 ? 48 : cs);
    const int tokc = seq0 + qr * 64 + qc;
    const bf16* qp = Z + (size_t)tokc * NZ + 6144 + h * 64;
    const bf16x8_t qf0 = *(const bf16x8_t*)(qp + 8 * q), qf1 = *(const bf16x8_t*)(qp + 32 + 8 * q);
    f32x4 s[16];
#pragma unroll
    for (int hf = 0; hf < 2; ++hf) {
        bf16x8_t kf[8][2];
#pragma unroll
        for (int tt = 0; tt < 8; ++tt) { const int t = 8 * hf + tt;
            const bf16* kp = zk + (size_t)((rs + (t >> 1)) * 64 + cbs + (t & 1) * 16 + n) * NZ + 8 * q;
            kf[tt][0] = *(const bf16x8_t*)kp; kf[tt][1] = *(const bf16x8_t*)(kp + 32); }
#pragma unroll
        for (int tt = 0; tt < 8; ++tt) {
            f32x4 a = {0.f, 0.f, 0.f, 0.f};
            a = __builtin_amdgcn_mfma_f32_16x16x32_bf16(kf[tt][0], qf0, a, 0, 0, 0);
            s[8 * hf + tt] = __builtin_amdgcn_mfma_f32_16x16x32_bf16(kf[tt][1], qf1, a, 0, 0, 0);
        }
        __builtin_amdgcn_sched_barrier(0);
    }
    const LAS float* rbp = (const LAS float*)(lds + C_ROWS * KPITCH);
    float m = -1e30f;
#pragma unroll
    for (int t = 0; t < 16; ++t)
#pragma unroll
        for (int j = 0; j < 4; ++j) {
            const int kr = rs + (t >> 1), kc = cbs + (t & 1) * 16 + 4 * q + j;
            const bool valid = (kc >= cs) && (kc < cs + 16);
            int dc = kc - qc + 15; dc = dc < 0 ? 0 : (dc > 30 ? 30 : dc);
            const float sc = s[t][j] * 0.125f + rbp[(kr - qr + 7) * 31 + dc];
            s[t][j] = valid ? sc : -1e30f; m = fmaxf(m, s[t][j]);
        }
    m = fmaxf(m, __shfl_xor(m, 16)); m = fmaxf(m, __shfl_xor(m, 32));
    float l = 0.f;
#pragma unroll
    for (int t = 0; t < 16; ++t)
#pragma unroll
        for (int j = 0; j < 4; ++j) { const float pe = __expf(s[t][j] - m); s[t][j] = pe; l += pe; }
    l += __shfl_xor(l, 16); l += __shfl_xor(l, 32);
    f32x4 o[4];
#pragma unroll
    for (int dt = 0; dt < 4; ++dt) o[dt] = (f32x4){0.f, 0.f, 0.f, 0.f};
    LAS unsigned char* vb = lds + ((rs - rb) * 64 + cbs + 4 * q + ((lane >> 2) & 3)) * KPITCH + 8 * (lane & 3);
#pragma unroll
    for (int G = 0; G < 8; ++G) {
        const bf16x8_t pb = packp(s[2 * G], s[2 * G + 1]);
#pragma unroll
        for (int dt = 0; dt < 4; ++dt) {
            const s16x4_t lo = trread(vb + (64 * G) * KPITCH + dt * 32), hi = trread(vb + (64 * G + 16) * KPITCH + dt * 32);
            o[dt] = __builtin_amdgcn_mfma_f32_16x16x32_bf16(cat4(lo, hi), pb, o[dt], 0, 0, 0);
        }
    }
    const float inv = 1.f / l;
    bf16* yp = Yc + (size_t)tokc * 512 + h * 64;
#pragma unroll
    for (int dt = 0; dt < 4; ++dt) { uint2 wv; wv.x = pg8::cvt_pk_bf16(o[dt][0] * inv, o[dt][1] * inv); wv.y = pg8::cvt_pk_bf16(o[dt][2] * inv, o[dt][3] * inv);
        *(uint2*)(yp + dt * 16 + 4 * q) = wv; }
    }
}

constexpr int VPITCH = 272;
constexpr int B1_V = 0, B1_KF = 128 * VPITCH, B1_KB = B1_KF + 128 * KPITCH;
__device__ __forceinline__ void mixB1_mfma_unit(const bf16* Z, float* ST, LAS unsigned char* lds, int gn, int hb, float lgf, float lgb, int tid) {
    const int lane = tid & 63, w = tid >> 6, n = lane & 15, q = lane >> 4;
    const bf16* zb = Z + (size_t)gn * 128 * NZ;
    __syncthreads();
    {
        pg8::u32x4 vbuf[4]; uint4 kbuf[2];
#pragma unroll
        for (int i = 0; i < 4; ++i) { const int c = tid + i * NTHR, row = c >> 4, ch = c & 15; vbuf[i] = *(const pg8::u32x4*)(zb + (size_t)row * NZ + 5120 + hb * 128 + ch * 8); }
#pragma unroll
        for (int i = 0; i < 2; ++i) { const int c = tid + i * NTHR, row = c >> 3, ch = c & 7; kbuf[i] = *(const uint4*)(zb + (size_t)row * NZ + 4864 + hb * 64 + ch * 8); }
#pragma unroll
        for (int i = 0; i < 4; ++i) { const int c = tid + i * NTHR, row = c >> 4, ch = c & 15; *(LAS pg8::u32x4*)(lds + B1_V + row * VPITCH + ch * 16) = vbuf[i]; }
#pragma unroll
        for (int i = 0; i < 2; ++i) { const int c = tid + i * NTHR, row = c >> 3, ch = c & 7;
            float k[8]; unpack8(kbuf[i], k);
            const float wf = 0.125f * __expf(lgf * (float)(127 - row)), wb = 0.125f * __expf(lgb * (float)row);
            pg8::u32x4 a, b;
            a.x = pg8::cvt_pk_bf16(k[0] * wf, k[1] * wf); a.y = pg8::cvt_pk_bf16(k[2] * wf, k[3] * wf); a.z = pg8::cvt_pk_bf16(k[4] * wf, k[5] * wf); a.w = pg8::cvt_pk_bf16(k[6] * wf, k[7] * wf);
            b.x = pg8::cvt_pk_bf16(k[0] * wb, k[1] * wb); b.y = pg8::cvt_pk_bf16(k[2] * wb, k[3] * wb); b.z = pg8::cvt_pk_bf16(k[4] * wb, k[5] * wb); b.w = pg8::cvt_pk_bf16(k[6] * wb, k[7] * wb);
            *(LAS pg8::u32x4*)(lds + B1_KF + row * KPITCH + ch * 16) = a; *(LAS pg8::u32x4*)(lds + B1_KB + row * KPITCH + ch * 16) = b; }
    }
    __syncthreads();
    f32x4 af[4], ab[4];
#pragma unroll
    for (int dt = 0; dt < 4; ++dt) { af[dt] = (f32x4){0.f, 0.f, 0.f, 0.f}; ab[dt] = (f32x4){0.f, 0.f, 0.f, 0.f}; }
    const int rsel = 4 * q + ((lane >> 2) & 3), csel = 8 * (lane & 3);
#pragma unroll
    for (int js = 0; js < 4; ++js) {
        LAS unsigned char* vp = lds + B1_V + (32 * js + rsel) * VPITCH + w * 32 + csel;
        const bf16x8_t va = cat4(trread(vp), trread(vp + 16 * VPITCH));
#pragma unroll
        for (int dt = 0; dt < 4; ++dt) {
            LAS unsigned char* kf = lds + B1_KF + (32 * js + rsel) * KPITCH + dt * 32 + csel;
            LAS unsigned char* kb = lds + B1_KB + (32 * js + rsel) * KPITCH + dt * 32 + csel;
            af[dt] = __builtin_amdgcn_mfma_f32_16x16x32_bf16(va, cat4(trread(kf), trread(kf + 16 * KPITCH)), af[dt], 0, 0, 0);
            ab[dt] = __builtin_amdgcn_mfma_f32_16x16x32_bf16(va, cat4(trread(kb), trread(kb + 16 * KPITCH)), ab[dt], 0, 0, 0);
        }
    }
    float* pf = ST + ((size_t)(0 * 4 + hb) * 128 + gn) * 8192 + 16 * w + 4 * q;
    float* pb = ST + ((size_t)(1 * 4 + hb) * 128 + gn) * 8192 + 16 * w + 4 * q;
#pragma unroll
    for (int dt = 0; dt < 4; ++dt) { *(f32x4*)(pf + (dt * 16 + n) * 128) = af[dt]; *(f32x4*)(pb + (dt * 16 + n) * 128) = ab[dt]; }
}
constexpr int B3_K = 0, B3_V = 128 * KPITCH, B3_SF = B3_V + 128 * VPITCH, B3_SB = B3_SF + 64 * VPITCH;
__device__ __forceinline__ void mixB3_mfma_unit(const bf16* Z, const float* ST, bf16* Yb, LAS unsigned char* lds, int gn, int hb, float lgf, float lgb, int tid) {
    const int lane = tid & 63, w = tid >> 6, n = lane & 15, q = lane >> 4;
    const bf16* zb = Z + (size_t)gn * 128 * NZ;
    const float* Sf = ST + ((size_t)(0 * 4 + hb) * 128 + gn) * 8192;
    const float* Sb = ST + ((size_t)(1 * 4 + hb) * 128 + gn) * 8192;
    __syncthreads();
    {
        pg8::u32x4 kbuf[2], vbuf[4]; f32x4 sbuf[4][2];
#pragma unroll
        for (int i = 0; i < 2; ++i) { const int c = tid + i * NTHR, row = c >> 3, ch = c & 7; kbuf[i] = *(const pg8::u32x4*)(zb + (size_t)row * NZ + 4864 + hb * 64 + ch * 8); }
#pragma unroll
        for (int i = 0; i < 4; ++i) { const int c = tid + i * NTHR, row = c >> 4, ch = c & 15; vbuf[i] = *(const pg8::u32x4*)(zb + (size_t)row * NZ + 5120 + hb * 128 + ch * 8); }
#pragma unroll
        for (int i = 0; i < 4; ++i) { const int c = tid + i * NTHR, dir = c >> 10, cc = c & 1023, row = cc >> 4, ch = cc & 15;
            const float* sp = (dir ? Sb : Sf) + row * 128 + ch * 8; sbuf[i][0] = *(const f32x4*)sp; sbuf[i][1] = *(const f32x4*)(sp + 4); }
#pragma unroll
        for (int i = 0; i < 2; ++i) { const int c = tid + i * NTHR, row = c >> 3, ch = c & 7; *(LAS pg8::u32x4*)(lds + B3_K + row * KPITCH + ch * 16) = kbuf[i]; }
#pragma unroll
        for (int i = 0; i < 4; ++i) { const int c = tid + i * NTHR, row = c >> 4, ch = c & 15; *(LAS pg8::u32x4*)(lds + B3_V + row * VPITCH + ch * 16) = vbuf[i]; }
#pragma unroll
        for (int i = 0; i < 4; ++i) { const int c = tid + i * NTHR, dir = c >> 10, cc = c & 1023, row = cc >> 4, ch = cc & 15;
            const f32x4 x0 = sbuf[i][0], x1 = sbuf[i][1];
            pg8::u32x4 a; a.x = pg8::cvt_pk_bf16(x0[0], x0[1]); a.y = pg8::cvt_pk_bf16(x0[2], x0[3]); a.z = pg8::cvt_pk_bf16(x1[0], x1[1]); a.w = pg8::cvt_pk_bf16(x1[2], x1[3]);
            *(LAS pg8::u32x4*)(lds + (dir ? B3_SB : B3_SF) + row * VPITCH + ch * 16) = a; }
    }
    __syncthreads();
    const int i = 16 * w + n, tokc = gn * 128 + i;
    const bf16* qp = Z + (size_t)tokc * NZ + 4608 + hb * 64;
    const int rsel = 4 * q + ((lane >> 2) & 3), csel = 8 * (lane & 3);
    f32x4 o[8];
    {
        const uint2 a0 = *(const uint2*)(qp + 4 * q), a1 = *(const uint2*)(qp + 16 + 4 * q), a2 = *(const uint2*)(qp + 32 + 4 * q), a3 = *(const uint2*)(qp + 48 + 4 * q);
        const bf16x8_t qc0 = __builtin_bit_cast(bf16x8_t, (uint4){a0.x, a0.y, a1.x, a1.y}), qc1 = __builtin_bit_cast(bf16x8_t, (uint4){a2.x, a2.y, a3.x, a3.y});
        const float cf = __expf(lgf * (float)(i + 1)), cb = __expf(lgb * (float)(128 - i));
#pragma unroll
        for (int et = 0; et < 8; ++et) {
            LAS unsigned char* sf = lds + B3_SF + rsel * VPITCH + et * 32 + csel;
            LAS unsigned char* sb = lds + B3_SB + rsel * VPITCH + et * 32 + csel;
            f32x4 f = {0.f, 0.f, 0.f, 0.f}, b = {0.f, 0.f, 0.f, 0.f};
            f = __builtin_amdgcn_mfma_f32_16x16x32_bf16(cat4(trread(sf), trread(sf + 16 * VPITCH)), qc0, f, 0, 0, 0);
            f = __builtin_amdgcn_mfma_f32_16x16x32_bf16(cat4(trread(sf + 32 * VPITCH), trread(sf + 48 * VPITCH)), qc1, f, 0, 0, 0);
            b = __builtin_amdgcn_mfma_f32_16x16x32_bf16(cat4(trread(sb), trread(sb + 16 * VPITCH)), qc0, b, 0, 0, 0);
            b = __builtin_amdgcn_mfma_f32_16x16x32_bf16(cat4(trread(sb + 32 * VPITCH), trread(sb + 48 * VPITCH)), qc1, b, 0, 0, 0);
            o[et] = f * cf + b * cb;
        }
    }
    {
        const bf16x8_t qf0 = *(const bf16x8_t*)(qp + 8 * q), qf1 = *(const bf16x8_t*)(qp + 32 + 8 * q);
        f32x4 s[8];
#pragma unroll
        for (int t = 0; t < 8; ++t) {
            LAS unsigned char* kp = lds + B3_K + (16 * t + n) * KPITCH + q * 16;
            f32x4 a = {0.f, 0.f, 0.f, 0.f};
            a = __builtin_amdgcn_mfma_f32_16x16x32_bf16(*(LAS bf16x8_t*)kp, qf0, a, 0, 0, 0);
            a = __builtin_amdgcn_mfma_f32_16x16x32_bf16(*(LAS bf16x8_t*)(kp + 64), qf1, a, 0, 0, 0);
#pragma unroll
            for (int j = 0; j < 4; ++j) { const int jj = 16 * t + 4 * q + j; const float dcy = (jj <= i) ? __expf(lgf * (float)(i - jj)) : __expf(lgb * (float)(jj - i)); a[j] = a[j] * 0.125f * dcy; }
            s[t] = a;
        }
#pragma unroll
        for (int G = 0; G < 4; ++G) {
            const bf16x8_t pb = packp(s[2 * G], s[2 * G + 1]);
#pragma unroll
            for (int et = 0; et < 8; ++et) {
                LAS unsigned char* vp = lds + B3_V + (32 * G + rsel) * VPITCH + et * 32 + csel;
                o[et] = __builtin_amdgcn_mfma_f32_16x16x32_bf16(cat4(trread(vp), trread(vp + 16 * VPITCH)), pb, o[et], 0, 0, 0);
            }
        }
    }
    float s1 = 0.f;
#pragma unroll
    for (int et = 0; et < 8; ++et) s1 += (o[et][0] + o[et][1]) + (o[et][2] + o[et][3]);
    s1 += __shfl_xor(s1, 16); s1 += __shfl_xor(s1, 32);
    const float mu = s1 * (1.f / 128.f);
    float s2 = 0.f;
#pragma unroll
    for (int et = 0; et < 8; ++et) { o[et] = o[et] - mu; s2 += (o[et][0] * o[et][0] + o[et][1] * o[et][1]) + (o[et][2] * o[et][2] + o[et][3] * o[et][3]); }
    s2 += __shfl_xor(s2, 16); s2 += __shfl_xor(s2, 32);
    const float rstd = 1.f / sqrtf(s2 * (1.f / 128.f) + GN_EPS);
    const bf16* gp = Z + (size_t)tokc * NZ + 5632 + hb * 128 + 4 * q;
    bf16* yp = Yb + (size_t)tokc * 512 + hb * 128 + 4 * q;
#pragma unroll
    for (int et = 0; et < 8; ++et) {
        const uint2 gw = *(const uint2*)(gp + et * 16);
        const float g0 = pg8::bflo(gw.x), g1 = pg8::bfhi(gw.x), g2 = pg8::bflo(gw.y), g3 = pg8::bfhi(gw.y);
        uint2 wv; wv.x = pg8::cvt_pk_bf16(o[et][0] * rstd * g0 * pg8::sigmoidf_(g0), o[et][1] * rstd * g1 * pg8::sigmoidf_(g1));
        wv.y = pg8::cvt_pk_bf16(o[et][2] * rstd * g2 * pg8::sigmoidf_(g2), o[et][3] * rstd * g3 * pg8::sigmoidf_(g3));
        *(uint2*)(yp + et * 16) = wv;
    }
}

#define RLX_AGENT __ATOMIC_RELAXED, __HIP_MEMORY_SCOPE_AGENT
#define XB_TMO      128
#define XB_XCNT(j)  (256  + 64 * (j))
#define XB_XSUB(j)  (1280 + 64 * (j))
#define XB_XGEN(j)  (2304 + 64 * (j))
#define XB_TOP      3328
#define XB_TOPGEN   3392
#define XCD_BAR_WORDS 3456
#define XB_SPIN_CAP (1u << 18)

__device__ __forceinline__ unsigned xb_ld(unsigned* p)              { return __hip_atomic_load(p, __ATOMIC_RELAXED, __HIP_MEMORY_SCOPE_AGENT); }
__device__ __forceinline__ unsigned xb_add(unsigned* p, unsigned v) { return __hip_atomic_fetch_add(p, v, __ATOMIC_RELAXED, __HIP_MEMORY_SCOPE_AGENT); }
__device__ __forceinline__ unsigned xb_xcc_id() { return (unsigned)__builtin_amdgcn_s_getreg((3 << 11) | 20) & 0xFu; }
#define XB_SPIN(cond, bar) do { unsigned _sp = 0; while (cond) { __builtin_amdgcn_s_sleep(1); \
    if ((++_sp & 255u) == 0u) { if (xb_ld(&(bar)[XB_TMO])) break; if (_sp > XB_SPIN_CAP) { atomicAdd(&(bar)[XB_TMO], 1u); break; } } } } while (0)

struct XcdBarrier {
    unsigned* bar; unsigned x;
    volatile LAS unsigned* st;
};

__device__ __forceinline__ XcdBarrier xcd_barrier_post(unsigned* bar, volatile LAS unsigned* st) {
    XcdBarrier b; b.bar = bar; b.x = xb_xcc_id(); b.st = st;
    if (threadIdx.x == 0) (void)xb_add(&bar[XB_XCNT(b.x)], 1u);
    return b;
}
__device__ __forceinline__ void xcd_barrier_complete(unsigned* bar, unsigned x, unsigned& nloc, unsigned& nx) {
    const unsigned G = gridDim.x * gridDim.y * gridDim.z;
    unsigned sum, cnt, mine, sp = 0u;
    for (;;) {
        sum = 0u; cnt = 0u; mine = 0u;
#pragma unroll
        for (unsigned j = 0; j < 16; ++j) { const unsigned c = xb_ld(&bar[XB_XCNT(j)]); sum += c; cnt += (c > 0u) ? 1u : 0u; mine = (j == x) ? c : mine; }
        if (sum == G) break;
        __builtin_amdgcn_s_sleep(1);
        if ((++sp & 255u) == 0u) { if (xb_ld(&bar[XB_TMO])) break; if (sp > XB_SPIN_CAP) { atomicAdd(&bar[XB_TMO], 1u); break; } }
    }
    nloc = mine > 0u ? mine : 1u; nx = cnt > 0u ? cnt : 1u;
}

__device__ __forceinline__ void xcd_barrier(const XcdBarrier& b) {
    asm volatile("s_waitcnt vmcnt(0)" ::: "memory");
    __syncthreads();
    if (threadIdx.x == 0) {
        unsigned* bar = b.bar;
        __builtin_amdgcn_s_waitcnt(0);
        unsigned nloc = b.st[0], nx = b.st[1];
        if (nloc == 0u) { xcd_barrier_complete(bar, b.x, nloc, nx); b.st[0] = nloc; b.st[1] = nx; }
        const unsigned old = xb_add(&bar[XB_XSUB(b.x)], 1u);
        const unsigned gen = old / nloc;
        if (old + 1u == (gen + 1u) * nloc) {
            __builtin_amdgcn_fence(__ATOMIC_RELEASE, "agent");
            asm volatile("s_waitcnt vmcnt(0)" ::: "memory");
            const unsigned og = xb_add(&bar[XB_TOP], 1u);
            const unsigned tg = og / nx;
            if (og + 1u == (tg + 1u) * nx) xb_add(&bar[XB_TOPGEN], 1u);
            else XB_SPIN(xb_ld(&bar[XB_TOPGEN]) == tg, bar);
            __builtin_amdgcn_fence(__ATOMIC_ACQUIRE, "agent");
            xb_add(&bar[XB_XGEN(b.x)], 1u);
            asm volatile("s_waitcnt vmcnt(0)" ::: "memory");
        } else {
            XB_SPIN(xb_ld(&bar[XB_XGEN(b.x)]) == gen, bar);
            __builtin_amdgcn_fence(__ATOMIC_ACQUIRE, "agent");
            asm volatile("s_waitcnt vmcnt(0)" ::: "memory");
        }
    }
    __syncthreads();
}

__device__ __forceinline__ float log_sigmoid_(float x) { return -log1pf(__expf(-x)); }
#ifndef PHMASK
#define PHMASK 0xFFFF
#endif
constexpr int NPHASE = 17;
__global__ void __launch_bounds__(NTHR, 2) fwd_megakernel(Params p) {
    extern __shared__ __attribute__((aligned(16))) unsigned char lds_raw[];
    cg::grid_group grid = cg::this_grid();
    LAS unsigned char* lds = (LAS unsigned char*)lds_raw;
    const int G = gridDim.x, bx = blockIdx.x;
    unsigned char* ws = p.ws;
    volatile LAS unsigned* bst = (volatile LAS unsigned*)(lds + 131072);
    if (threadIdx.x < 4) bst[threadIdx.x] = 0u;
    __syncthreads();
    if (ws == nullptr) grid.sync();
    const XcdBarrier xbar = xcd_barrier_post((unsigned*)ws, bst);

#pragma unroll 1
    for (int L = 0; L < DEPTH; ++L) {
        convert_weights(p, L, lds, G);
        xcd_barrier(xbar);
#pragma unroll 1
        for (int P = 0; P < 2; ++P) {
#pragma unroll 1
            for (int ph = 0; ph < NPHASE; ++ph) {
                const int sub = ph < 3 ? ph : (ph < 15 ? 3 + (ph - 3) % 6 : ph - 6);
                const int ci = (ph >= 9 && ph < 15) ? 1 : 0;
                bf16* WB = (bf16*)(ws + WS_W); bf16* XBp = (bf16*)(ws + WS_XB); bf16* XBc = XBp + (size_t)ci * MC * D;
                bf16* Zb = (bf16*)(ws + WS_Z); bf16* Hb = (bf16*)(ws + WS_Z); bf16* MG = (bf16*)(ws + WS_Z);
                float* PART = (float*)(ws + WS_PART); bf16* GT = (bf16*)(ws + WS_G); bf16* Y = (bf16*)(ws + WS_Y); float* ST = (float*)XBc; float* LSEb = (float*)(ws + WS_LSE);
                float* EXb = (float*)(ws + WS_Y);
                unsigned* CNT = (unsigned*)(ws + WS_CNT);
                float* Xp = p.out + (size_t)P * 2 * MC * D; float* Xc = Xp + (size_t)ci * MC * D;
                const float* xinp = p.in[P];
                const int S = (P == 0) ? 8192 : 16384, nseq = MC / S;
                const bool isgemm = (sub == 1 || sub == 2 || sub == 3 || sub == 7 || sub == 8 || sub == 9 || sub == 10);
                if (isgemm) {
                    pg8::Gemm g; pg8::Sched So;
                    typedef unsigned long long u64;
                    u64 ep[10]; int mode = 0;
#pragma unroll
                    for (int i = 0; i < 10; ++i) ep[i] = 0;
                    if (sub == 1 || sub == 9) { g = pg8::Gemm{XBp, WB + (sub == 1 ? WO_W1C : WO_W2C), 2 * MC, 2 * FF, D}; So.init(2 * MC, 2 * FF, 1, G, bx, 4); mode = 0; ep[1] = (u64)Hb; }
                    else if (sub == 2) { g = pg8::Gemm{Hb, WB + WO_W1D, 2 * MC, D, FF}; So.init(2 * MC, D, 1, G, bx); mode = 1;
                        ep[1] = (u64)(L == 0 ? xinp : Xp); ep[2] = (u64)Xp; ep[3] = (u64)XBp; ep[4] = (u64)EXb; ep[5] = (u64)(p.in[5] + L * D); ep[6] = (u64)(p.in[6] + L * D); ep[7] = (u64)CNT;
                        ep[8] = (u64)__float_as_uint(ALPHA) | ((u64)__float_as_uint(0.5f) << 32); ep[9] = (u64)(unsigned)(4 * (3 * L + 1)) | ((u64)(unsigned)(P * 128) << 32); }
                    else if (sub == 10) { g = pg8::Gemm{Hb, WB + WO_W2D, 2 * MC, D, FF}; So.init(2 * MC, D, 1, G, bx); mode = 1;
                        ep[1] = (u64)Xp; ep[2] = (u64)Xp; ep[3] = (u64)XBp; ep[4] = (u64)EXb; ep[5] = (u64)(p.in[20] + L * D); ep[6] = (u64)(p.in[21] + L * D); ep[7] = (u64)CNT;
                        ep[8] = (u64)__float_as_uint(ALPHA) | ((u64)__float_as_uint(0.5f) << 32); ep[9] = (u64)(unsigned)(4 * (3 * L + 3)) | ((u64)(unsigned)(P * 128) << 32); }
                    else if (sub == 3) { g = pg8::Gemm{XBc, WB + WO_WIN, MC, DIN, D}; So.init(MC, DIN, 1, G, bx, 4); mode = 2; ep[1] = (u64)Zb; ep[2] = (u64)GT; }
                    else if (sub == 7) { g = pg8::Gemm{Y, WB + WO_PBR, 3 * MC, 3 * D, 512}; So.init(MC, D, 3, G, bx); mode = 3; ep[1] = (u64)GT; ep[2] = (u64)PART; ep[3] = (u64)MG; }
                    else { g = pg8::Gemm{MG, WB + WO_WOUT, MC, D, D}; So.init(MC, D, 1, G, bx); mode = 1;
                        ep[1] = (u64)Xc; ep[2] = (u64)Xc; ep[3] = (u64)XBc; ep[4] = (u64)EXb; ep[5] = (u64)(p.in[15] + L * D); ep[6] = (u64)(p.in[16] + L * D); ep[7] = (u64)CNT;
                        ep[8] = (u64)__float_as_uint(ALPHA) | ((u64)__float_as_uint(1.0f) << 32); ep[9] = (u64)(unsigned)(4 * (3 * L + 2)) | ((u64)(unsigned)(P * 128 + ci * 64) << 32); }
                    ep[0] = (u64)(unsigned)mode;
                    if (threadIdx.x == 0) {
                        LAS u64* epl = (LAS u64*)(lds + 131072 + 64 + 2240);
#pragma unroll
                        for (int i = 0; i < 10; ++i) epl[i] = ep[i];
                    }
                    __syncthreads();
                    if (mode == 1) pg8::gemm_phase(lds, g, So, pg8::EpiAll<1>{}); else if (mode == 3) pg8::gemm_phase(lds, g, So, pg8::EpiAll<2>{}); else pg8::gemm_phase(lds, g, So, pg8::EpiAll<0>{});
                } else {
                    int tid = threadIdx.x; asm volatile("" : "+v"(tid));
                    const int gtid = bx * NTHR + tid, gthreads = G * NTHR;
                    if (sub == 0) {
                        convert_rows(L == 0 ? xinp : Xp, XBp, 2 * MC, gtid, gthreads);
                    } else if (sub == 4) {
                        constexpr int NB1 = 128 * 4, NA = 3 * 512, NC = 64 * 8;
                        const float* rpb = p.in[10] + L * 8 * 15 * 31;
                        int it = bx;
#pragma unroll 1
                        for (; it < NB1; it += G) { int t2 = tid; asm volatile("" : "+v"(t2)); const int gn = it >> 2, hb = it & 3;
                            mixB1_mfma_unit(Zb, ST, lds, gn, hb, log_sigmoid_(p.in[8][L * 4 + hb]), log_sigmoid_(p.in[9][L * 4 + hb]), t2); }
                        if (it < NB1 + NA) {
                            pg8::u32x4 abuf[A_NIT];
                            { int t2 = tid; asm volatile("" : "+v"(t2)); mixA_load(Zb, it - NB1, S, t2, abuf); }
#pragma unroll 1
                            for (; it < NB1 + NA; it += G) {
                                int t2 = tid; asm volatile("" : "+v"(t2));
                                __syncthreads(); mixA_store(lds, t2, abuf); __syncthreads();
                                if (it + G < NB1 + NA) mixA_load(Zb, it + G - NB1, S, t2, abuf);
                                mixA_compute(Zb, LSEb, lds, it - NB1, S, t2);
                            }
                        }
#pragma unroll 1
                        for (; it < NB1 + NA + NC; it += G) { int t2 = tid; asm volatile("" : "+v"(t2)); mixC_mfma_unit(Zb, Y + (size_t)2 * MC * 512, rpb, lds, it - NB1 - NA, S, t2); }
                    } else if (sub == 5) {
                        mixB2(ST, S, nseq, p.in[8] + L * 4, p.in[9] + L * 4, gtid, gthreads);
                    } else if (sub == 6) {
#pragma unroll 1
                        for (int it = bx; it < 128 * 4; it += G) { const int gn = it >> 2, hb = it & 3; int t2 = tid; asm volatile("" : "+v"(t2));
                            mixB3_mfma_unit(Zb, ST, Y + (size_t)MC * 512, lds, gn, hb, log_sigmoid_(p.in[8][L * 4 + hb]), log_sigmoid_(p.in[9][L * 4 + hb]), t2); }
                        mixA_merge(Zb, LSEb, Y, gtid, gthreads);
                    }
                }
                xcd_barrier(xbar);
            }
        }
    }
}

extern "C" void kernel_launch(void* const* d_in, const int* in_sizes, int n_in, void* d_out, int out_size, void* d_ws, size_t ws_size, hipStream_t stream) {
    static int grid = 0;
    if (grid == 0) {
        if (n_in != 22 || out_size != NTOK * D || ws_size < WS_END) { fprintf(stderr, "kernel_launch: unexpected shapes (n_in %d out %d ws %zu)\n", n_in, out_size, ws_size); grid = -1; return; }
        int dev = 0, cus = 0, per_cu = 0;
        hipGetDevice(&dev);
        hipDeviceGetAttribute(&cus, hipDeviceAttributeMultiprocessorCount, dev);
        hipFuncSetAttribute((const void*)fwd_megakernel, hipFuncAttributeMaxDynamicSharedMemorySize, LDS_BYTES);
        hipOccupancyMaxActiveBlocksPerMultiprocessor(&per_cu, (const void*)fwd_megakernel, NTHR, LDS_BYTES);
        if (per_cu < 1) { fprintf(stderr, "kernel_launch: occupancy query gives %d\n", per_cu); per_cu = 1; }
        (void)hipGetLastError();
        grid = cus * 1;
    }
    if (grid < 0) return;
    if (hipMemsetAsync(d_ws, 0, 32768, stream) != hipSuccess) { fprintf(stderr, "kernel_launch: memset of barrier words failed\n"); return; }
    Params p{};
    for (int i = 0; i < 22; ++i) p.in[i] = (const float*)d_in[i];
    p.out = (float*)d_out; p.ws = (unsigned char*)d_ws;
    void* args[] = {&p};
    hipError_t e = hipLaunchCooperativeKernel((const void*)fwd_megakernel, dim3(grid), dim3(NTHR), args, LDS_BYTES, stream);
    if (e != hipSuccess) fprintf(stderr, "cooperative launch failed: %s (grid %d)\n", hipGetErrorString(e), grid);
}
```

```cpp
#include <hip/hip_runtime.h>
#include <hip/hip_cooperative_groups.h>
#include <cstdio>
#include <cstdint>
namespace cg = cooperative_groups;

namespace pg8 {
#define PG8_LAS __attribute__((address_space(3)))
typedef unsigned short bf16_t;
typedef short bf16x8 __attribute__((ext_vector_type(8)));
typedef float f32x4 __attribute__((ext_vector_type(4)));
typedef unsigned u32x4 __attribute__((ext_vector_type(4)));
constexpr int BM = 256, BK = 64, HALF = 128, HTB = HALF * BK * 2, STAGE_BYTES = 8 * HTB, NXCD = 8, WGM = 8;

__host__ __device__ __forceinline__ int lds_byte(int r, int c) { const int st = (r >> 4) * 2 + (c >> 5), rr = r & 15, cc = c & 31, ob = rr * 64 + cc * 2; return st * 1024 + (ob ^ (((ob >> 9) & 1) << 5)); }
__host__ __device__ __forceinline__ void stage_rc(int b, int& R, int& C) { const int st = b / 1024, sb = b % 1024, swz = sb ^ (((sb >> 9) & 1) << 5); R = (st >> 1) * 16 + swz / 64; C = (st & 1) * 32 + (swz % 64) / 2; }
__host__ __device__ __forceinline__ int perm32(int rho) { const int n = rho >> 4, i = rho & 15; return 8 * (i >> 2) + 4 * n + (i & 3); }

struct Unit { int pm, pn; };
struct Gemm { const bf16_t* A; const bf16_t* Bt; int M, N, K; };

struct StaticOrder {
    int nM, nN, nwg, G, c, wgm;
    __host__ __device__ void init(int M, int N, int G_, int c_, int wgm_ = WGM) { nM = M / BM; nN = N / BM; nwg = nM * nN; G = G_; c = c_; wgm = wgm_; }
    __host__ __device__ bool next(int i, Unit& u) const {
        const long L = (long)i * G + c; if (L >= nwg) return false;
        int wgid = (int)L; { const int q = nwg / NXCD, r = nwg % NXCD, xcd = wgid % NXCD, off = wgid / NXCD; wgid = (xcd < r ? xcd * (q + 1) : r * (q + 1) + (xcd - r) * q) + off; }
        const int nig = wgm * nN, gid = wgid / nig, fm = gid * wgm, gsz = (nM - fm) < wgm ? (nM - fm) : wgm;
        u.pm = fm + ((wgid % nig) % gsz); u.pn = (wgid % nig) / gsz; return true;
    }
};
struct Sched {
    StaticOrder S0; int nbr, nMt, nNt;
    __device__ void init(int M, int N, int nbr_, int G_, int c_, int wgm_ = WGM) { S0.init(M, N, G_, c_, wgm_); nbr = nbr_; nMt = M / BM; nNt = N / BM; }
    __device__ bool next(int i, Unit& u) const {
        if (nbr == 1) return S0.next(i, u);
        Unit t; if (!S0.next(i / 3, t)) return false; const int b = i % 3; u.pm = b * nMt + t.pm; u.pn = b * nNt + t.pn; return true; }
    __device__ bool carry(int i) const { return nbr == 3 && (i % 3) != 2; }
};

__device__ __forceinline__ unsigned cvt_pk_bf16(float lo, float hi) { unsigned r; asm volatile("v_cvt_pk_bf16_f32 %0, %1, %2" : "=v"(r) : "v"(lo), "v"(hi)); return r; }
__device__ __forceinline__ float bflo(unsigned w) { return __uint_as_float(w << 16); }
__device__ __forceinline__ float bfhi(unsigned w) { return __uint_as_float(w & 0xffff0000u); }
__device__ __forceinline__ float sigmoidf_(float x) { return __builtin_amdgcn_rcpf(1.f + __expf(-x)); }

struct EpiSwiglu {
    static constexpr bool PERM = true;
    bf16_t* H; int ldh;
    __device__ __forceinline__ void operator()(const f32x4 (&acc)[2][2][4][2], const Unit& u, int wr, int wc, int fr, int fq) const {
        const int row0 = u.pm * BM + wr * 64 + fr, col0 = u.pn * HALF + wc * 32 + 8 * fq;
#pragma unroll
        for (int ai = 0; ai < 2; ++ai)
#pragma unroll
            for (int m = 0; m < 4; ++m) {
                f32x4 hv[2];
#pragma unroll
                for (int n = 0; n < 2; ++n) {
                    const f32x4 g = acc[ai][0][m][n], up = acc[ai][1][m][n];
                    const f32x4 t = g * (-1.44269504088896341f);
                    f32x4 d; d[0] = __builtin_amdgcn_exp2f(t[0]); d[1] = __builtin_amdgcn_exp2f(t[1]); d[2] = __builtin_amdgcn_exp2f(t[2]); d[3] = __builtin_amdgcn_exp2f(t[3]);
                    d = d + 1.0f;
                    f32x4 r; r[0] = __builtin_amdgcn_rcpf(d[0]); r[1] = __builtin_amdgcn_rcpf(d[1]); r[2] = __builtin_amdgcn_rcpf(d[2]); r[3] = __builtin_amdgcn_rcpf(d[3]);
                    hv[n] = (g * up) * r;
                }
                u32x4 w; w.x = cvt_pk_bf16(hv[0][0], hv[0][1]); w.y = cvt_pk_bf16(hv[0][2], hv[0][3]); w.z = cvt_pk_bf16(hv[1][0], hv[1][1]); w.w = cvt_pk_bf16(hv[1][2], hv[1][3]);
                *(u32x4*)(H + (size_t)(row0 + ai * HALF + m * 16) * ldh + col0) = w;
            }
    }
};
struct EpiResid {
    static constexpr bool PERM = true;
    const float* Xin; float* Xout; bf16_t* XB; float* EX; const float* gam; const float* bet; unsigned* cnt; unsigned target; int pbase; float alpha, s;
    __device__ __forceinline__ void operator()(f32x4 (&acc)[2][2][4][2], const Unit& u, int wr, int wc, int fr, int fq, PG8_LAS float* sl) const {
        const int tid = threadIdx.x;
        const int lr0 = wr * 64 + fr, col0 = u.pn * BM + wc * 32 + 8 * fq;
        PG8_LAS float* red = sl + 1008;
#pragma unroll
        for (int ai = 0; ai < 2; ++ai) {
            f32x4 xl[4][2][2];
#pragma unroll
            for (int m = 0; m < 4; ++m)
#pragma unroll
                for (int bj = 0; bj < 2; ++bj) {
                    const size_t off = (size_t)(u.pm * BM + lr0 + ai * HALF + m * 16) * 1024 + col0 + bj * HALF;
                    xl[m][bj][0] = *(const f32x4*)(Xin + off); xl[m][bj][1] = *(const f32x4*)(Xin + off + 4);
                }
#pragma unroll
            for (int m = 0; m < 4; ++m) {
                const int lr = lr0 + ai * HALF + m * 16;
                float rs = 0.f, rq = 0.f;
#pragma unroll
                for (int bj = 0; bj < 2; ++bj) {
                    const f32x4 x0 = xl[m][bj][0] * alpha + acc[ai][bj][m][0] * s, x1 = xl[m][bj][1] * alpha + acc[ai][bj][m][1] * s;
                    acc[ai][bj][m][0] = x0; acc[ai][bj][m][1] = x1;
                    rs += (x0[0] + x0[1]) + (x0[2] + x0[3]) + (x1[0] + x1[1]) + (x1[2] + x1[3]);
                    rq += (x0[0] * x0[0] + x0[1] * x0[1]) + (x0[2] * x0[2] + x0[3] * x0[3]) + (x1[0] * x1[0] + x1[1] * x1[1]) + (x1[2] * x1[2] + x1[3] * x1[3]);
                }
                rs += __shfl_xor(rs, 16); rs += __shfl_xor(rs, 32); rq += __shfl_xor(rq, 16); rq += __shfl_xor(rq, 32);
                if (fq == 0) { red[(wc * 256 + lr) * 2] = rs; red[(wc * 256 + lr) * 2 + 1] = rq; }
            }
            __builtin_amdgcn_sched_barrier(0);
        }
        asm volatile("s_waitcnt lgkmcnt(0)" ::: "memory"); __builtin_amdgcn_s_barrier();
        const int panel = pbase + u.pm;
        if (tid < 256) {
            float a = 0.f, b = 0.f;
#pragma unroll
            for (int k = 0; k < 4; ++k) { a += red[(k * 256 + tid) * 2]; b += red[(k * 256 + tid) * 2 + 1]; }
            float* ex = EX + ((size_t)(panel * 4 + u.pn) * 256 + tid) * 2;
            __hip_atomic_store(ex, a, __ATOMIC_RELAXED, __HIP_MEMORY_SCOPE_AGENT); __hip_atomic_store(ex + 1, b, __ATOMIC_RELAXED, __HIP_MEMORY_SCOPE_AGENT);
        }
        asm volatile("s_waitcnt vmcnt(0)" ::: "memory"); __builtin_amdgcn_s_barrier();
        if (tid == 0) {
            __hip_atomic_fetch_add(cnt + panel, 1u, __ATOMIC_RELAXED, __HIP_MEMORY_SCOPE_AGENT);
            unsigned sp = 0;
            while (__hip_atomic_load(cnt + panel, __ATOMIC_RELAXED, __HIP_MEMORY_SCOPE_AGENT) < target) { __builtin_amdgcn_s_sleep(1); if (++sp > (1u << 22)) break; }
        }
        __builtin_amdgcn_s_barrier();
        if (tid < 256) {
            float a = 0.f, b = 0.f;
#pragma unroll
            for (int k = 0; k < 4; ++k) { const float* ex = EX + ((size_t)(panel * 4 + k) * 256 + tid) * 2;
                a += __hip_atomic_load(ex, __ATOMIC_RELAXED, __HIP_MEMORY_SCOPE_AGENT); b += __hip_atomic_load(ex + 1, __ATOMIC_RELAXED, __HIP_MEMORY_SCOPE_AGENT); }
            const float mu = a * (1.f / 1024.f), var = fmaxf(b * (1.f / 1024.f) - mu * mu, 0.f);
            sl[2 * tid] = mu; sl[2 * tid + 1] = 1.f / sqrtf(var + 1e-5f);
        }
        asm volatile("s_waitcnt lgkmcnt(0)" ::: "memory"); __builtin_amdgcn_s_barrier();
#pragma unroll
        for (int bj = 0; bj < 2; ++bj) {
            const int col = col0 + bj * HALF;
            const f32x4 g0 = *(const f32x4*)(gam + col), g1 = *(const f32x4*)(gam + col + 4), b0 = *(const f32x4*)(bet + col), b1 = *(const f32x4*)(bet + col + 4);
#pragma unroll
            for (int ai = 0; ai < 2; ++ai)
#pragma unroll
                for (int m = 0; m < 4; ++m) {
                    const int lr = lr0 + ai * HALF + m * 16; const float mu = sl[2 * lr], rstd = sl[2 * lr + 1];
                    const size_t off = (size_t)(u.pm * BM + lr) * 1024 + col;
                    const f32x4 y0 = (acc[ai][bj][m][0] - mu) * rstd * g0 + b0, y1 = (acc[ai][bj][m][1] - mu) * rstd * g1 + b1;
                    *(f32x4*)(Xout + off) = y0; *(f32x4*)(Xout + off + 4) = y1;
                    u32x4 w; w.x = cvt_pk_bf16(y0[0], y0[1]); w.y = cvt_pk_bf16(y0[2], y0[3]); w.z = cvt_pk_bf16(y1[0], y1[1]); w.w = cvt_pk_bf16(y1[2], y1[3]);
                    *(u32x4*)(XB + off) = w;
                    __builtin_amdgcn_sched_barrier(0);
                }
        }
    }
};
struct EpiWin {
    static constexpr bool PERM = true;
    bf16_t* Z; bf16_t* Gt;
    __device__ __forceinline__ void operator()(const f32x4 (&acc)[2][2][4][2], const Unit& u, int wr, int wc, int fr, int fq) const {
        const int row0 = u.pm * BM + wr * 64 + fr; const bool isg = u.pn >= 30;
        bf16_t* base = isg ? Gt : Z; const int ld = isg ? 3072 : 7680; const int col0 = (isg ? (u.pn - 30) : u.pn) * BM + wc * 32 + 8 * fq;
#pragma unroll
        for (int ai = 0; ai < 2; ++ai)
#pragma unroll
            for (int m = 0; m < 4; ++m)
#pragma unroll
                for (int bj = 0; bj < 2; ++bj) {
                    f32x4 v0 = acc[ai][bj][m][0], v1 = acc[ai][bj][m][1];
                    if (isg) {
#pragma unroll
                        for (int j = 0; j < 4; ++j) { v0[j] = 1.f + __builtin_amdgcn_exp2f(v0[j] * -1.44269504088896341f); v1[j] = 1.f + __builtin_amdgcn_exp2f(v1[j] * -1.44269504088896341f); }
                    }
                    u32x4 w; w.x = cvt_pk_bf16(v0[0], v0[1]); w.y = cvt_pk_bf16(v0[2], v0[3]); w.z = cvt_pk_bf16(v1[0], v1[1]); w.w = cvt_pk_bf16(v1[2], v1[3]);
                    *(u32x4*)(base + (size_t)(row0 + ai * HALF + m * 16) * ld + col0 + bj * HALF) = w;
                }
    }
};
struct EpiBranch {
    static constexpr bool PERM = true;
    const bf16_t* Gt; bf16_t* Mg; int nMt;
    __device__ __forceinline__ void operator()(f32x4 (&acc)[2][2][4][2], const Unit& u, int wr, int wc, int fr, int fq) const {
        const int b = u.pm / nMt, pm = u.pm - b * nMt, pn = u.pn - b * 4;
        const int row0 = pm * BM + wr * 64 + fr, col0 = pn * BM + wc * 32 + 8 * fq;
#pragma unroll
        for (int ai = 0; ai < 2; ++ai) {
            u32x4 gw[4][2], gn[4][2];
#pragma unroll
            for (int m = 0; m < 4; ++m)
#pragma unroll
                for (int bj = 0; bj < 2; ++bj) {
                    const size_t row = (size_t)(row0 + ai * HALF + m * 16); const int col = col0 + bj * HALF;
                    gw[m][bj] = *(const u32x4*)(Gt + row * 3072 + b * 1024 + col);
                    if (b < 2) gn[m][bj] = *(const u32x4*)(Gt + row * 3072 + (b + 1) * 1024 + col); else gn[m][bj] = gw[m][bj];
                }
#pragma unroll
            for (int m = 0; m < 4; ++m)
#pragma unroll
                for (int bj = 0; bj < 2; ++bj) {
                    const u32x4 g = gw[m][bj], h = gn[m][bj];
                    f32x4 g0 = {bflo(g.x), bfhi(g.x), bflo(g.y), bfhi(g.y)}, g1 = {bflo(g.z), bfhi(g.z), bflo(g.w), bfhi(g.w)};
                    if (b < 2) {
                        const f32x4 h0 = {bflo(h.x), bfhi(h.x), bflo(h.y), bfhi(h.y)}, h1 = {bflo(h.z), bfhi(h.z), bflo(h.w), bfhi(h.w)};
#pragma unroll
                        for (int j = 0; j < 4; ++j) { g0[j] = h0[j] * __builtin_amdgcn_rcpf(g0[j]); g1[j] = h1[j] * __builtin_amdgcn_rcpf(g1[j]); }
                        acc[ai][bj][m][0] = acc[ai][bj][m][0] * g0; acc[ai][bj][m][1] = acc[ai][bj][m][1] * g1;
                    } else {
                        const size_t row = (size_t)(row0 + ai * HALF + m * 16); const int col = col0 + bj * HALF;
#pragma unroll
                        for (int j = 0; j < 4; ++j) { g0[j] = __builtin_amdgcn_rcpf(g0[j]); g1[j] = __builtin_amdgcn_rcpf(g1[j]); }
                        const f32x4 v0 = acc[ai][bj][m][0] * g0, v1 = acc[ai][bj][m][1] * g1;
                        u32x4 w; w.x = cvt_pk_bf16(v0[0], v0[1]); w.y = cvt_pk_bf16(v0[2], v0[3]); w.z = cvt_pk_bf16(v1[0], v1[1]); w.w = cvt_pk_bf16(v1[2], v1[3]);
                        *(u32x4*)(Mg + row * 1024 + col) = w;
                    }
                }
            __builtin_amdgcn_sched_barrier(0);
        }
    }
};

__device__ __forceinline__ unsigned long long ldsu64(PG8_LAS const unsigned long long* p) {
    const unsigned long long v = *p; const unsigned lo = __builtin_amdgcn_readfirstlane((unsigned)v), hi = __builtin_amdgcn_readfirstlane((unsigned)(v >> 32));
    return ((unsigned long long)hi << 32) | lo;
}
template <int KIND  > struct EpiAll {
    static constexpr bool PERM = true;
    __device__ __forceinline__ void operator()(f32x4 (&acc)[2][2][4][2], const Unit& u, int wr, int wc, int fr, int fq, PG8_LAS float* sl) const {
        asm volatile("" : "+v"(fr), "+v"(fq), "+s"(wr), "+s"(wc));
        PG8_LAS const unsigned long long* ep = (PG8_LAS const unsigned long long*)((PG8_LAS unsigned char*)sl + 2240);
        if constexpr (KIND == 1) { const unsigned long long as = ldsu64(ep + 8), tp = ldsu64(ep + 9);
            EpiResid e{(const float*)ldsu64(ep + 1), (float*)ldsu64(ep + 2), (bf16_t*)ldsu64(ep + 3), (float*)ldsu64(ep + 4), (const float*)ldsu64(ep + 5), (const float*)ldsu64(ep + 6),
                       (unsigned*)ldsu64(ep + 7), (unsigned)tp, (int)(unsigned)(tp >> 32), __uint_as_float((unsigned)as), __uint_as_float((unsigned)(as >> 32))}; e(acc, u, wr, wc, fr, fq, sl); }
        else if constexpr (KIND == 2) { EpiBranch e{(const bf16_t*)ldsu64(ep + 1), (bf16_t*)ldsu64(ep + 3), 64}; e(acc, u, wr, wc, fr, fq); }
        else {
            const unsigned long long s0 = ldsu64(ep); const int mode = (int)(unsigned)s0;
            if (mode == 0) { EpiSwiglu e{(bf16_t*)ldsu64(ep + 1), 2816}; e(acc, u, wr, wc, fr, fq); }
            else { EpiWin e{(bf16_t*)ldsu64(ep + 1), (bf16_t*)ldsu64(ep + 2)}; e(acc, u, wr, wc, fr, fq); }
        }
    }
};

template <class Epi, class Sched>
__device__ __forceinline__ void gemm_phase(PG8_LAS unsigned char* lds, const Gemm g, const Sched& S, const Epi& E) {
    int tid = threadIdx.x; asm volatile("" : "+v"(tid));
    const int wid = __builtin_amdgcn_readfirstlane(tid >> 6), lane = tid & 63, wr = wid >> 2, wc = wid & 3, fr = lane & 15, fq = lane >> 4;
    const int K = g.K, nt = K / BK;
    unsigned voffA[2], voffB[2];
#pragma unroll
    for (int i = 0; i < 2; ++i) { int R, C; stage_rc(tid * 16 + i * 8192, R, C); const int Rb = Epi::PERM ? ((R & ~31) + perm32(R & 31)) : R;
        voffA[i] = (unsigned)(R * K + C) * 2u; voffB[i] = (unsigned)(Rb * K + C) * 2u; }
    const size_t kstep = (size_t)(BK * 2);
    const size_t hstep = (size_t)HALF * K * 2;
    const size_t tstep = 2 * hstep;
    const unsigned ldsw = (unsigned)wid * 1024u;
    const int aoff = lds_byte(wr * 64 + fr, fq * 8), boff = lds_byte(wc * 32 + fr, fq * 8);
#define PG8_SA(b, h) (((b) * 2 + (h)) * HTB)
#define PG8_SB(b, h) ((4 + (b) * 2 + (h)) * HTB)
#define PG8_STAGE(bufoff, gbase, voff) do { _Pragma("unroll") for (int _i = 0; _i < 2; ++_i) \
        __builtin_amdgcn_global_load_lds((const unsigned*)((const char*)(gbase) + (voff)[_i]), (PG8_LAS unsigned*)(lds + (bufoff) + ldsw + _i * 8192), 16, 0, 0); } while (0)
#define PG8_LDA(dst, b, h) do { _Pragma("unroll") for (int m = 0; m < 4; ++m) _Pragma("unroll") for (int k = 0; k < 2; ++k) dst[m][k] = *(const PG8_LAS bf16x8*)(lds + PG8_SA(b, h) + aoff + m * 2048 + k * 1024); } while (0)
#define PG8_LDB(dst, b, h) do { _Pragma("unroll") for (int n = 0; n < 2; ++n) _Pragma("unroll") for (int k = 0; k < 2; ++k) dst[n][k] = *(const PG8_LAS bf16x8*)(lds + PG8_SB(b, h) + boff + n * 2048 + k * 1024); } while (0)
#define PG8_MMA(ai, bj, At, Bt) do { __builtin_amdgcn_s_setprio(1); _Pragma("unroll") for (int m = 0; m < 4; ++m) _Pragma("unroll") for (int n = 0; n < 2; ++n) _Pragma("unroll") for (int k = 0; k < 2; ++k) \
        acc[ai][bj][m][n] = __builtin_amdgcn_mfma_f32_16x16x32_bf16(Bt[n][k], At[m][k], acc[ai][bj][m][n], 0, 0, 0); __builtin_amdgcn_s_setprio(0); } while (0)
#define PG8_WAIT_V(n) asm volatile("s_waitcnt vmcnt(" #n ")" ::: "memory")
#define PG8_WAIT_L(n) asm volatile("s_waitcnt lgkmcnt(" #n ")" ::: "memory")
#define PG8_BAR __builtin_amdgcn_s_barrier()
#define PG8_SCHED __builtin_amdgcn_sched_barrier(0)
    Unit cur, nxt; int ui = 0;
    if (!S.next(0, cur)) return;
    f32x4 acc[2][2][4][2];
#pragma unroll
    for (int a = 0; a < 2; ++a)
#pragma unroll
        for (int b = 0; b < 2; ++b)
#pragma unroll
            for (int m = 0; m < 4; ++m)
#pragma unroll
                for (int n = 0; n < 2; ++n) acc[a][b][m][n] = (f32x4){0.f, 0.f, 0.f, 0.f};
    bf16x8 At[4][2], B0[2][2], B1[2][2];
    const char* cA = (const char*)g.A + (size_t)cur.pm * tstep; const char* cB = (const char*)g.Bt + (size_t)cur.pn * tstep;
    PG8_STAGE(PG8_SB(0, 0), cB, voffB); PG8_STAGE(PG8_SB(0, 1), cB + hstep, voffB); PG8_STAGE(PG8_SA(0, 0), cA, voffA); PG8_STAGE(PG8_SA(0, 1), cA + hstep, voffA);
    if (wr == 1) PG8_BAR;
    PG8_WAIT_V(2); PG8_BAR;
    PG8_STAGE(PG8_SB(1, 0), cB + kstep, voffB); PG8_STAGE(PG8_SA(1, 0), cA + kstep, voffA); PG8_STAGE(PG8_SB(1, 1), cB + hstep + kstep, voffB);
    PG8_WAIT_V(6); PG8_BAR;
    for (;;) {
        const bool has_next = S.next(ui + 1, nxt);
        const char* nA = has_next ? (const char*)g.A + (size_t)nxt.pm * tstep : cA; const char* nB = has_next ? (const char*)g.Bt + (size_t)nxt.pn * tstep : cB;
        for (int t = 0; t < nt; t += 2) {
            const bool last = (t == nt - 2);
            const char* a1 = cA + (size_t)(t + 1) * kstep;
            const char* a2 = last ? nA : cA + (size_t)(t + 2) * kstep; const char* b2 = last ? nB : cB + (size_t)(t + 2) * kstep;
            const char* a3 = a2 + kstep; const char* b3 = b2 + kstep;
            PG8_LDB(B0, 0, 0); PG8_LDB(B1, 0, 1); PG8_SCHED; PG8_LDA(At, 0, 0); PG8_STAGE(PG8_SA(1, 1), a1 + hstep, voffA);
            PG8_WAIT_V(8); PG8_WAIT_L(0); PG8_BAR; PG8_MMA(0, 0, At, B0); PG8_MMA(0, 1, At, B1); PG8_BAR; PG8_SCHED;
            PG8_LDA(At, 0, 1); PG8_STAGE(PG8_SB(0, 0), b2, voffB); PG8_STAGE(PG8_SB(0, 1), b2 + hstep, voffB); PG8_STAGE(PG8_SA(0, 0), a2, voffA);
            PG8_WAIT_V(8); PG8_WAIT_L(0); PG8_BAR; PG8_MMA(1, 0, At, B0); PG8_MMA(1, 1, At, B1); PG8_BAR; PG8_SCHED;
            PG8_LDB(B0, 1, 0); PG8_LDB(B1, 1, 1); PG8_SCHED; PG8_LDA(At, 1, 0); PG8_STAGE(PG8_SA(0, 1), a2 + hstep, voffA);
            PG8_WAIT_V(8); PG8_WAIT_L(0); PG8_BAR; PG8_MMA(0, 0, At, B0); PG8_MMA(0, 1, At, B1); PG8_BAR; PG8_SCHED;
            PG8_LDA(At, 1, 1); PG8_STAGE(PG8_SB(1, 0), b3, voffB); PG8_STAGE(PG8_SB(1, 1), b3 + hstep, voffB); PG8_STAGE(PG8_SA(1, 0), a3, voffA);
            PG8_WAIT_V(8); PG8_WAIT_L(0); PG8_BAR; PG8_MMA(1, 0, At, B0); PG8_MMA(1, 1, At, B1); PG8_BAR; PG8_SCHED;
        }
        if (wr == 0) PG8_BAR;
        E(acc, cur, wr, wc, fr, fq, (PG8_LAS float*)(lds + 131072 + 64));
        if (!has_next) break;
        if (!S.carry(ui))
#pragma unroll
        for (int a = 0; a < 2; ++a)
#pragma unroll
            for (int b = 0; b < 2; ++b)
#pragma unroll
                for (int m = 0; m < 4; ++m)
#pragma unroll
                    for (int n = 0; n < 2; ++n) acc[a][b][m][n] = (f32x4){0.f, 0.f, 0.f, 0.f};
        cur = nxt; cA = nA; cB = nB; ++ui;
        if (wr == 1) PG8_BAR;
    }
    PG8_WAIT_V(0);
    PG8_BAR;
#undef PG8_SA
#undef PG8_SB
#undef PG8_STAGE
#undef PG8_LDA
#undef PG8_LDB
#undef PG8_MMA
#undef PG8_WAIT_V
#undef PG8_WAIT_L
#undef PG8_BAR
#undef PG8_SCHED
}
}

typedef unsigned short bf16;
typedef float f32x4 __attribute__((ext_vector_type(4)));
#define LAS __attribute__((address_space(3)))
constexpr int D = 1024, FF = 2816, NZ = 7680, NGATE = 3072, DIN = 10752;
constexpr int NTOK = 65536, MC = 16384, NCHUNK = 4, DEPTH = 2;
constexpr int NWAVES = 8, NTHR = 512;
constexpr float ALPHA = 1.41421356237309515f;
constexpr float LN_EPS = 1e-5f, GN_EPS = 1e-5f;
constexpr size_t MiB = 1u << 20;
constexpr size_t WO_W1C = 0, WO_W1D = WO_W1C + (size_t)2 * FF * D, WO_WIN = WO_W1D + (size_t)D * FF, WO_PBR = WO_WIN + (size_t)DIN * D,
                 WO_WOUT = WO_PBR + (size_t)3 * D * 512, WO_W2C = WO_WOUT + (size_t)D * D, WO_W2D = WO_W2C + (size_t)2 * FF * D, WO_END = WO_W2D + (size_t)D * FF;
constexpr size_t WS_CNT = 16384;
constexpr size_t WS_W = 1 * MiB, WS_XB = 61 * MiB  , WS_Z = 125 * MiB, WS_PART = 157 * MiB, WS_G = 365 * MiB, WS_Y = 461 * MiB, WS_LSE = 509 * MiB, WS_END = 511 * MiB;
static_assert(WS_W + WO_END * 2 <= WS_XB && WS_XB + (size_t)2 * MC * D * 2 <= WS_Z, "weights / Xb fit");
static_assert(WS_Z + (size_t)MC * NZ * 2 <= WS_G && WS_Z + (size_t)2 * MC * FF * 2 <= WS_G && WS_PART + (size_t)MC * D * 4 <= WS_G && WS_Z + (size_t)MC * D * 2 <= WS_PART, "Z overlays (H of a pair, merged, partial)");
static_assert(WS_G + (size_t)MC * NGATE * 2 <= WS_Y && WS_Y + (size_t)3 * MC * 512 * 2 <= WS_LSE && (size_t)2 * 4 * 128 * 8192 * 4 <= (size_t)MC * D * 2 && WS_LSE + (size_t)3 * MC * 8 * 4 <= WS_END, "ws map");
constexpr int LDS_BYTES = 131072 + 16384;

struct Params { const float* in[22]; float* out; unsigned char* ws; };

__device__ __forceinline__ float bf2f(bf16 v) { return __uint_as_float(((unsigned)v) << 16); }
__device__ __forceinline__ unsigned f2bf(float f) { unsigned u = __builtin_bit_cast(unsigned, f); return (u + 0x7fffu + ((u >> 16) & 1u)) >> 16; }
__device__ __forceinline__ unsigned pk2(float lo, float hi) { return f2bf(lo) | (f2bf(hi) << 16); }
__device__ __forceinline__ void unpack8(const uint4 w, float* f) {
    f[0] = pg8::bflo(w.x); f[1] = pg8::bfhi(w.x); f[2] = pg8::bflo(w.y); f[3] = pg8::bfhi(w.y);
    f[4] = pg8::bflo(w.z); f[5] = pg8::bfhi(w.z); f[6] = pg8::bflo(w.w); f[7] = pg8::bfhi(w.w);
}
__device__ __forceinline__ float wave_sum(float v) {
#pragma unroll
    for (int o = 1; o < 64; o <<= 1) v += __shfl_xor(v, o);
    return v;
}

__device__ __forceinline__ void transpose_item(const float* W, int K, int N, bf16* WT, int kb, int n0, int row_base, LAS float* scr, int lane, const float* gvec) {
    const int k0 = 64 * kb;
#pragma unroll 8
    for (int i = 0; i < 32; ++i) { const int kk = 2 * i + (lane >> 5); scr[kk * 33 + (lane & 31)] = W[(size_t)(k0 + kk) * N + n0 + (lane & 31)]; }
    asm volatile("s_waitcnt lgkmcnt(0)" ::: "memory");
    const int c = lane & 7;
#pragma unroll
    for (int j = 0; j < 4; ++j) { const int n = (lane >> 3) + 8 * j; const LAS float* s = scr + (8 * c) * 33 + n;
        uint4 o; o.x = pk2(s[0 * 33], s[1 * 33]); o.y = pk2(s[2 * 33], s[3 * 33]); o.z = pk2(s[4 * 33], s[5 * 33]); o.w = pk2(s[6 * 33], s[7 * 33]);
        *(uint4*)(WT + (size_t)(row_base + n) * K + k0 + 8 * c) = o; }
    asm volatile("s_waitcnt lgkmcnt(0)" ::: "memory");
}
__device__ __forceinline__ void convert_weights(const Params& p, int L, LAS unsigned char* lds, int G) {
    int tid = threadIdx.x; asm volatile("" : "+v"(tid));
    const int lane = tid & 63, wave = __builtin_amdgcn_readfirstlane(tid >> 6);
    const int gw = blockIdx.x * NWAVES + wave, NGW = G * NWAVES;
    LAS float* scr = (LAS float*)(lds + wave * 16384);
    bf16* WB = (bf16*)(p.ws + WS_W);
    constexpr int I_UP = (D / 64) * (FF / 32), I_DN = (FF / 64) * (D / 32), I_IN = (D / 64) * (DIN / 32), I_BR = (512 / 64) * (D / 32), I_OUT = (D / 64) * (D / 32);
    constexpr int NITEMS = 4 * I_UP + 2 * I_DN + I_IN + 3 * I_BR + I_OUT;
#pragma unroll 1
    for (int it = gw; it < NITEMS; it += NGW) {
        int r = it; const float* W; int K, N, mode = 0, row_off = 0; size_t wo; const float* gv = nullptr;
        const float* gin1 = L ? p.in[20] + (size_t)(L - 1) * D : nullptr;
        if (r < I_UP) { W = p.in[2] + (size_t)L * D * FF; K = D; N = FF; mode = 1; wo = WO_W1C; }
        else if ((r -= I_UP) < I_UP) { W = p.in[3] + (size_t)L * D * FF; K = D; N = FF; mode = 2; wo = WO_W1C; }
        else if ((r -= I_UP) < I_DN) { W = p.in[4] + (size_t)L * FF * D; K = FF; N = D; wo = WO_W1D; }
        else if ((r -= I_DN) < I_IN) { W = p.in[7] + (size_t)L * D * DIN; K = D; N = DIN; wo = WO_WIN; }
        else if ((r -= I_IN) < I_BR) { W = p.in[11] + (size_t)L * 512 * D; K = 512; N = D; wo = WO_PBR; }
        else if ((r -= I_BR) < I_BR) { W = p.in[12] + (size_t)L * 512 * D; K = 512; N = D; wo = WO_PBR; row_off = 1024; }
        else if ((r -= I_BR) < I_BR) { W = p.in[13] + (size_t)L * 512 * D; K = 512; N = D; wo = WO_PBR; row_off = 2048; }
        else if ((r -= I_BR) < I_OUT) { W = p.in[14] + (size_t)L * D * D; K = D; N = D; wo = WO_WOUT; }
        else if ((r -= I_OUT) < I_UP) { W = p.in[17] + (size_t)L * D * FF; K = D; N = FF; mode = 1; wo = WO_W2C; }
        else if ((r -= I_UP) < I_UP) { W = p.in[18] + (size_t)L * D * FF; K = D; N = FF; mode = 2; wo = WO_W2C; }
        else { r -= I_UP; W = p.in[19] + (size_t)L * FF * D; K = FF; N = D; wo = WO_W2D; }
        const int nblk = N / 32, kb = r / nblk, n0 = (r % nblk) * 32;
        int row_base = row_off + n0;
        if (mode) row_base = (n0 >> 7) * 256 + (mode == 2 ? 128 : 0) + (n0 & 127);
        int ln = lane; asm volatile("" : "+v"(ln));
        transpose_item(W, K, N, WB + wo, kb, n0, row_base, scr, ln, gv);
    }
}

__device__ __forceinline__ void convert_rows(const float* src, bf16* xb, int nrows, int gtid, int gthreads) {
    const int n4 = nrows * (D / 4);
    for (int i = gtid; i < n4; i += 4 * gthreads) {
        f32x4 v[4];
#pragma unroll
        for (int k = 0; k < 4; ++k) { const int j = i + k * gthreads; if (j < n4) v[k] = __builtin_nontemporal_load((const f32x4*)src + j); }
#pragma unroll
        for (int k = 0; k < 4; ++k) { const int j = i + k * gthreads; if (j < n4) { uint2 o; o.x = pk2(v[k].x, v[k].y); o.y = pk2(v[k].z, v[k].w); ((uint2*)xb)[j] = o; } }
    }
}
template <bool FINAL>
__device__ __forceinline__ void ln_pass(float* V, bf16* xb, float* RS, const float* g, const float* b, int nrows, int gw, int NGW, int lane) {
    f32x4 gv[4], bv[4];
#pragma unroll
    for (int j = 0; j < 4; ++j) { gv[j] = ((const f32x4*)g)[lane + 64 * j]; bv[j] = ((const f32x4*)b)[lane + 64 * j]; }
    for (int m = gw; m < nrows; m += NGW) {
        f32x4* xr = (f32x4*)(V + (size_t)m * D) + lane;
        f32x4 v[4]; float s = 0.f;
#pragma unroll
        for (int j = 0; j < 4; ++j) { v[j] = xr[64 * j]; s += (v[j].x + v[j].y) + (v[j].z + v[j].w); }
        const float mean = wave_sum(s) * (1.f / D); float s2 = 0.f;
#pragma unroll
        for (int j = 0; j < 4; ++j) { v[j] = v[j] - mean; s2 += (v[j].x * v[j].x + v[j].y * v[j].y) + (v[j].z * v[j].z + v[j].w * v[j].w); }
        const float rstd = 1.f / sqrtf(wave_sum(s2) * (1.f / D) + LN_EPS);
        if (FINAL) {
#pragma unroll
            for (int j = 0; j < 4; ++j) xr[64 * j] = v[j] * rstd * gv[j] + bv[j];
        } else {
            if (lane == 0) { float2 st; st.x = mean; st.y = rstd; *(float2*)(RS + (size_t)m * 2) = st; }
            uint2* o8 = (uint2*)(xb + (size_t)m * D) + lane;
#pragma unroll
            for (int j = 0; j < 4; ++j) { const f32x4 y = v[j] * rstd * gv[j] + bv[j]; uint2 o; o.x = pk2(y.x, y.y); o.y = pk2(y.z, y.w); o8[64 * j] = o; }
        }
    }
}

__device__ __forceinline__ void mixA_unit(const bf16* Z, bf16* Ya, int tc0, int S, int h, int tid) {
    const int ql = tid >> 3, sub = tid & 7;
    const int tc = tc0 + ql, seq0 = (tc / S) * S, t = tc - seq0;
    const bf16* zq = Z + (size_t)tc * NZ;
    const float slope = exp2f(-(float)(h + 1));
    float m = -1e30f, l = 0.f, o[8];
#pragma unroll
    for (int i = 0; i < 8; ++i) o[i] = 0.f;
#pragma unroll 1
    for (int g = 0; g < 3; ++g) {
        const int dil = 1 << (2 * g);
        float q[8]; unpack8(*(const uint4*)(zq + g * 512 + h * 64 + sub * 8), q);
#pragma unroll
        for (int i = 0; i < 8; ++i) q[i] *= 0.125f;
        const bf16* kbase = Z + (size_t)seq0 * NZ + 1536 + g * 512 + h * 64 + sub * 8;
#pragma unroll 1
        for (int jj = 0; jj <= 128; ++jj) {
            const int j = jj - 64, s = t + j * dil; const bool valid = (s >= 0) && (s < S); const int sc_ = valid ? s : t;
            const bf16* kp = kbase + (size_t)sc_ * NZ;
            float k[8], v[8]; unpack8(*(const uint4*)kp, k); unpack8(*(const uint4*)(kp + 1536), v);
            float dot = 0.f;
#pragma unroll
            for (int i = 0; i < 8; ++i) dot += q[i] * k[i];
            dot += __shfl_xor(dot, 1); dot += __shfl_xor(dot, 2); dot += __shfl_xor(dot, 4);
            const float sc = dot - slope * (float)((j < 0 ? -j : j) * dil);
            const float mn = valid ? fmaxf(m, sc) : m;
            const float corr = __expf(m - mn), pe = valid ? __expf(sc - mn) : 0.f;
            l = l * corr + pe;
#pragma unroll
            for (int i = 0; i < 8; ++i) o[i] = o[i] * corr + pe * v[i];
            m = mn;
        }
    }
    const float inv = 1.f / l;
    uint4 w; w.x = pk2(o[0] * inv, o[1] * inv); w.y = pk2(o[2] * inv, o[3] * inv); w.z = pk2(o[4] * inv, o[5] * inv); w.w = pk2(o[6] * inv, o[7] * inv);
    *(uint4*)(Ya + (size_t)tc * 512 + h * 64 + sub * 8) = w;
}
__device__ __forceinline__ void mixC_unit(const bf16* Z, bf16* Yc, const float* rpb, int tc0, int S, int h, int tid) {
    const int ql = tid >> 3, sub = tid & 7;
    const int tc = tc0 + ql, seq0 = (tc / S) * S, t = tc - seq0;
    const int rows = S / 64, qr = t >> 6, qc = t & 63;
    int rs = qr - 4; rs = rs < 0 ? 0 : (rs > rows - 8 ? rows - 8 : rs);
    int cs = qc - 8; cs = cs < 0 ? 0 : (cs > 48 ? 48 : cs);
    float q[8]; unpack8(*(const uint4*)(Z + (size_t)tc * NZ + 6144 + h * 64 + sub * 8), q);
#pragma unroll
    for (int i = 0; i < 8; ++i) q[i] *= 0.125f;
    const bf16* kbase = Z + (size_t)seq0 * NZ + 6656 + h * 64 + sub * 8;
    const float* rb = rpb + h * 15 * 31;
    float m = -1e30f, l = 0.f, o[8];
#pragma unroll
    for (int i = 0; i < 8; ++i) o[i] = 0.f;
#pragma unroll 2
    for (int kk = 0; kk < 128; ++kk) {
        const int kr = rs + (kk >> 4), kc = cs + (kk & 15), s = kr * 64 + kc;
        const bf16* kp = kbase + (size_t)s * NZ;
        float k[8], v[8]; unpack8(*(const uint4*)kp, k); unpack8(*(const uint4*)(kp + 512), v);
        float dot = 0.f;
#pragma unroll
        for (int i = 0; i < 8; ++i) dot += q[i] * k[i];
        dot += __shfl_xor(dot, 1); dot += __shfl_xor(dot, 2); dot += __shfl_xor(dot, 4);
        const float sc = dot + rb[(kr - qr + 7) * 31 + (kc - qc + 15)];
        const float mn = fmaxf(m, sc);
        const float corr = __expf(m - mn), pe = __expf(sc - mn);
        l = l * corr + pe;
#pragma unroll
        for (int i = 0; i < 8; ++i) o[i] = o[i] * corr + pe * v[i];
        m = mn;
    }
    const float inv = 1.f / l;
    uint4 w; w.x = pk2(o[0] * inv, o[1] * inv); w.y = pk2(o[2] * inv, o[3] * inv); w.z = pk2(o[4] * inv, o[5] * inv); w.w = pk2(o[6] * inv, o[7] * inv);
    *(uint4*)(Yc + (size_t)tc * 512 + h * 64 + sub * 8) = w;
}
__device__ __forceinline__ void mixB1_unit(const bf16* Z, float* ST, int gn, int hb, float lgf, float lgb, int tid) {
    const int d = tid >> 3, eb = (tid & 7) * 16;
    float f[16], b[16];
#pragma unroll
    for (int i = 0; i < 16; ++i) { f[i] = 0.f; b[i] = 0.f; }
    const bf16* zb = Z + (size_t)gn * 128 * NZ;
#pragma unroll 2
    for (int j = 0; j < 128; ++j) {
        const bf16* zr = zb + (size_t)j * NZ;
        const float kd = bf2f(zr[4864 + hb * 64 + d]) * 0.125f;
        float v[16]; unpack8(*(const uint4*)(zr + 5120 + hb * 128 + eb), v); unpack8(*(const uint4*)(zr + 5120 + hb * 128 + eb + 8), v + 8);
        const float wf = kd * __expf(lgf * (float)(127 - j)), wb = kd * __expf(lgb * (float)j);
#pragma unroll
        for (int i = 0; i < 16; ++i) { f[i] += wf * v[i]; b[i] += wb * v[i]; }
    }
    float* pf = ST + ((size_t)(0 * 4 + hb) * 128 + gn) * 8192 + d * 128 + eb;
    float* pb = ST + ((size_t)(1 * 4 + hb) * 128 + gn) * 8192 + d * 128 + eb;
#pragma unroll
    for (int i = 0; i < 4; ++i) { ((f32x4*)pf)[i] = (f32x4){f[4 * i], f[4 * i + 1], f[4 * i + 2], f[4 * i + 3]}; ((f32x4*)pb)[i] = (f32x4){b[4 * i], b[4 * i + 1], b[4 * i + 2], b[4 * i + 3]}; }
}
__device__ __forceinline__ float log_sigmoid2_(float x) { return -log1pf(__expf(-x)); }
__device__ __forceinline__ void mixB2(float* ST, int S, int nseq, const float* lgf4, const float* lgb4, int gtid, int gthreads) {
    const int N = S / 128, total = 2 * 4 * nseq * 8192;
    for (int id = gtid; id < total; id += gthreads) {
        const int el = id & 8191; int r = id >> 13; const int sq = r % nseq; r /= nseq; const int hb = r & 3, dir = r >> 2;
        const float lg = log_sigmoid2_(dir ? lgb4[hb] : lgf4[hb]); const float decay = __expf(lg * 128.f);
        float* p = ST + ((size_t)(dir * 4 + hb) * 128 + sq * N) * 8192 + el;
        float s = 0.f;
        for (int n0 = 0; n0 < N; n0 += 8) {
            float tmp[8];
#pragma unroll
            for (int i = 0; i < 8; ++i) { const int n = dir ? (N - 1 - (n0 + i)) : (n0 + i); tmp[i] = p[(size_t)n * 8192]; }
#pragma unroll
            for (int i = 0; i < 8; ++i) { const int n = dir ? (N - 1 - (n0 + i)) : (n0 + i); p[(size_t)n * 8192] = s; s = decay * s + tmp[i]; }
        }
    }
}
__device__ __forceinline__ void mixB3_unit(const bf16* Z, const float* ST, bf16* Yb, int gn, int hb, float lgf, float lgb, int tid) {
    const int i = tid >> 2, sub = tid & 3;
    const int tc = gn * 128 + i;
    const bf16* zq = Z + (size_t)tc * NZ;
    float q[64];
#pragma unroll
    for (int c = 0; c < 8; ++c) unpack8(*(const uint4*)(zq + 4608 + hb * 64 + c * 8), q + c * 8);
    float o[32];
#pragma unroll
    for (int e = 0; e < 32; ++e) o[e] = 0.f;
    const bf16* zb = Z + (size_t)gn * 128 * NZ;
#pragma unroll 1
    for (int j = 0; j < 128; ++j) {
        const bf16* zr = zb + (size_t)j * NZ;
        float dot = 0.f;
#pragma unroll
        for (int c = 0; c < 8; ++c) { float k[8]; unpack8(*(const uint4*)(zr + 4864 + hb * 64 + c * 8), k);
#pragma unroll
            for (int x = 0; x < 8; ++x) dot += q[c * 8 + x] * k[x]; }
        const float w = dot * 0.125f * (j <= i ? __expf(lgf * (float)(i - j)) : __expf(lgb * (float)(j - i)));
#pragma unroll
        for (int c = 0; c < 4; ++c) { float v[8]; unpack8(*(const uint4*)(zr + 5120 + hb * 128 + sub * 32 + c * 8), v);
#pragma unroll
            for (int x = 0; x < 8; ++x) o[c * 8 + x] += w * v[x]; }
    }
    const float cf = __expf(lgf * (float)(i + 1)), cb = __expf(lgb * (float)(128 - i));
    const float* Sf = ST + ((size_t)(0 * 4 + hb) * 128 + gn) * 8192 + sub * 32;
    const float* Sb = ST + ((size_t)(1 * 4 + hb) * 128 + gn) * 8192 + sub * 32;
#pragma unroll 2
    for (int d = 0; d < 64; ++d) {
        const float qd = bf2f(zq[4608 + hb * 64 + d]); const float a = qd * cf, b = qd * cb;
#pragma unroll
        for (int c = 0; c < 8; ++c) { const f32x4 sf = ((const f32x4*)(Sf + d * 128))[c], sb = ((const f32x4*)(Sb + d * 128))[c];
            o[4 * c] += a * sf.x + b * sb.x; o[4 * c + 1] += a * sf.y + b * sb.y; o[4 * c + 2] += a * sf.z + b * sb.z; o[4 * c + 3] += a * sf.w + b * sb.w; }
    }
    float s1 = 0.f;
#pragma unroll
    for (int e = 0; e < 32; ++e) s1 += o[e];
    s1 += __shfl_xor(s1, 1); s1 += __shfl_xor(s1, 2);
    const float mu = s1 * (1.f / 128.f);
    float s2 = 0.f;
#pragma unroll
    for (int e = 0; e < 32; ++e) { o[e] -= mu; s2 += o[e] * o[e]; }
    s2 += __shfl_xor(s2, 1); s2 += __shfl_xor(s2, 2);
    const float rstd = 1.f / sqrtf(s2 * (1.f / 128.f) + GN_EPS);
#pragma unroll
    for (int c = 0; c < 4; ++c) {
        float gt[8]; unpack8(*(const uint4*)(zq + 5632 + hb * 128 + sub * 32 + c * 8), gt);
        float y[8];
#pragma unroll
        for (int x = 0; x < 8; ++x) y[x] = o[c * 8 + x] * rstd * gt[x] * pg8::sigmoidf_(gt[x]);
        uint4 w; w.x = pk2(y[0], y[1]); w.y = pk2(y[2], y[3]); w.z = pk2(y[4], y[5]); w.w = pk2(y[6], y[7]);
        *(uint4*)(Yb + (size_t)tc * 512 + hb * 128 + sub * 32 + c * 8) = w;
    }
}

typedef short bf16x8_t __attribute__((ext_vector_type(8)));
typedef short s16x4_t __attribute__((ext_vector_type(4)));
__device__ __forceinline__ s16x4_t trread(LAS unsigned char* p) { return __builtin_amdgcn_ds_read_tr16_b64_v4i16((LAS s16x4_t*)p); }
__device__ __forceinline__ bf16x8_t cat4(s16x4_t a, s16x4_t b) { return (bf16x8_t){a[0], a[1], a[2], a[3], b[0], b[1], b[2], b[3]}; }
__device__ __forceinline__ bf16x8_t packp(f32x4 a, f32x4 b) {
    uint4 w; w.x = pg8::cvt_pk_bf16(a[0], a[1]); w.y = pg8::cvt_pk_bf16(a[2], a[3]); w.z = pg8::cvt_pk_bf16(b[0], b[1]); w.w = pg8::cvt_pk_bf16(b[2], b[3]);
    return __builtin_bit_cast(bf16x8_t, w);
}
constexpr int KPITCH = 144;
constexpr int A_ROWS = 400, A_VOFF = A_ROWS * KPITCH;
constexpr int A_TOT = 2 * A_ROWS * 8, A_NIT = (A_TOT + NTHR - 1) / NTHR;
__device__ __forceinline__ void mixA_load(const bf16* Z, int u, int S, int tid, pg8::u32x4 (&buf)[A_NIT]) {
    const int g = u >> 9, h = u & 7, tt = (u >> 3) & 63;
    const int dil = 1 << (2 * g), Lg = S / dil, tps = S >> 8, tpr = Lg >> 8;
    const int sq = tt / tps, x = tt - sq * tps, r = x / tpr, i0 = (x - r * tpr) << 8;
    const bf16* zk = Z + (size_t)(sq * S) * NZ + 1536 + g * 512 + h * 64;
#pragma unroll
    for (int i = 0; i < A_NIT; ++i) {
        const int c = tid + i * NTHR; const int mat = c >= A_ROWS * 8, cc = c - mat * A_ROWS * 8, row = cc >> 3, ch = cc & 7, idx = i0 - 64 + row;
        buf[i] = (pg8::u32x4){0u, 0u, 0u, 0u};
        if (c < A_TOT && idx >= 0 && idx < Lg) buf[i] = *(const pg8::u32x4*)(zk + (size_t)(idx * dil + r) * NZ + mat * 1536 + ch * 8);
    }
}
__device__ __forceinline__ void mixA_store(LAS unsigned char* lds, int tid, const pg8::u32x4 (&buf)[A_NIT]) {
#pragma unroll
    for (int i = 0; i < A_NIT; ++i) {
        const int c = tid + i * NTHR; const int mat = c >= A_ROWS * 8, cc = c - mat * A_ROWS * 8, row = cc >> 3, ch = cc & 7;
        if (c < A_TOT) *(LAS pg8::u32x4*)(lds + mat * A_VOFF + row * KPITCH + ch * 16) = buf[i];
    }
}
__device__ __forceinline__ void mixA_compute(bf16* Z, float* LSE, LAS unsigned char* lds, int u, int S, int tid) {
    const int g = u >> 9, h = u & 7, tt = (u >> 3) & 63;
    const int dil = 1 << (2 * g), Lg = S / dil, tps = S >> 8, tpr = Lg >> 8;
    const int sq = tt / tps, x = tt - sq * tps, r = x / tpr, i0 = (x - r * tpr) << 8;
    const int seq0 = sq * S;
    const int lane = tid & 63, w = tid >> 6, n = lane & 15, q = lane >> 4;
#pragma unroll
    for (int qt = 0; qt < 2; ++qt) {
    const int wt = 2 * w + qt;
    const int iq = i0 + 16 * wt + n, tokc = seq0 + iq * dil + r;
    bf16* qp = Z + (size_t)tokc * NZ + g * 512 + h * 64;
    const bf16x8_t qf0 = *(const bf16x8_t*)(qp + 8 * q), qf1 = *(const bf16x8_t*)(qp + 32 + 8 * q);
    f32x4 s[10];
#pragma unroll
    for (int t = 0; t < 9; ++t) {
        LAS unsigned char* kp = lds + (16 * wt + 16 * t + n) * KPITCH + q * 16;
        const bf16x8_t kf0 = *(LAS bf16x8_t*)kp, kf1 = *(LAS bf16x8_t*)(kp + 64);
        f32x4 a = {0.f, 0.f, 0.f, 0.f};
        a = __builtin_amdgcn_mfma_f32_16x16x32_bf16(kf0, qf0, a, 0, 0, 0);
        s[t] = __builtin_amdgcn_mfma_f32_16x16x32_bf16(kf1, qf1, a, 0, 0, 0);
    }
    s[9] = (f32x4){0.f, 0.f, 0.f, 0.f};
    const float slope = exp2f(-(float)(h + 1)) * (float)dil;
    float m = -1e30f;
#pragma unroll
    for (int t = 0; t < 9; ++t)
#pragma unroll
        for (int j = 0; j < 4; ++j) {
            const int rel = 16 * t + 4 * q + j - 64 - n, idxk = i0 - 64 + 16 * wt + 16 * t + 4 * q + j;
            const bool valid = (rel >= -64) && (rel <= 64) && (idxk >= 0) && (idxk < Lg);
            const float sc = s[t][j] * 0.125f - slope * (float)(rel < 0 ? -rel : rel);
            s[t][j] = valid ? sc : -1e30f; m = fmaxf(m, s[t][j]);
        }
    m = fmaxf(m, __shfl_xor(m, 16)); m = fmaxf(m, __shfl_xor(m, 32));
    float l = 0.f;
#pragma unroll
    for (int t = 0; t < 9; ++t)
#pragma unroll
        for (int j = 0; j < 4; ++j) { const float pe = __expf(s[t][j] - m); s[t][j] = pe; l += pe; }
    l += __shfl_xor(l, 16); l += __shfl_xor(l, 32);
    f32x4 o[4];
#pragma unroll
    for (int dt = 0; dt < 4; ++dt) o[dt] = (f32x4){0.f, 0.f, 0.f, 0.f};
    LAS unsigned char* vb = lds + A_VOFF + (16 * wt + 4 * q + ((lane >> 2) & 3)) * KPITCH + 8 * (lane & 3);
#pragma unroll
    for (int G = 0; G < 5; ++G) {
        const bf16x8_t pb = packp(s[2 * G], s[2 * G + 1]);
#pragma unroll
        for (int dt = 0; dt < 4; ++dt) {
            const s16x4_t lo = trread(vb + (32 * G) * KPITCH + dt * 32), hi = trread(vb + (32 * G + 16) * KPITCH + dt * 32);
            o[dt] = __builtin_amdgcn_mfma_f32_16x16x32_bf16(cat4(lo, hi), pb, o[dt], 0, 0, 0);
        }
    }
    const float inv = 1.f / l;
#pragma unroll
    for (int dt = 0; dt < 4; ++dt) { uint2 wv; wv.x = pg8::cvt_pk_bf16(o[dt][0] * inv, o[dt][1] * inv); wv.y = pg8::cvt_pk_bf16(o[dt][2] * inv, o[dt][3] * inv);
        *(uint2*)(qp + dt * 16 + 4 * q) = wv; }
    if (q == 0) LSE[((size_t)g * MC + tokc) * 8 + h] = m + __logf(l);
    }
}
__device__ __forceinline__ void mixA_merge(const bf16* Z, const float* LSE, bf16* Ya, int gtid, int gthreads) {
    for (int it = gtid; it < MC * 64; it += gthreads) {
        const int tok = it >> 6, h = (it >> 3) & 7, ch = it & 7;
        const float l0 = LSE[((size_t)0 * MC + tok) * 8 + h], l1 = LSE[((size_t)1 * MC + tok) * 8 + h], l2 = LSE[((size_t)2 * MC + tok) * 8 + h];
        const float mx = fmaxf(l0, fmaxf(l1, l2));
        float w0 = __expf(l0 - mx), w1 = __expf(l1 - mx), w2 = __expf(l2 - mx); const float inv = 1.f / (w0 + w1 + w2); w0 *= inv; w1 *= inv; w2 *= inv;
        const bf16* zp = Z + (size_t)tok * NZ + h * 64 + ch * 8;
        float a[8], b[8], c[8]; unpack8(*(const uint4*)zp, a); unpack8(*(const uint4*)(zp + 512), b); unpack8(*(const uint4*)(zp + 1024), c);
        uint4 wv; wv.x = pk2(w0 * a[0] + w1 * b[0] + w2 * c[0], w0 * a[1] + w1 * b[1] + w2 * c[1]); wv.y = pk2(w0 * a[2] + w1 * b[2] + w2 * c[2], w0 * a[3] + w1 * b[3] + w2 * c[3]);
        wv.z = pk2(w0 * a[4] + w1 * b[4] + w2 * c[4], w0 * a[5] + w1 * b[5] + w2 * c[5]); wv.w = pk2(w0 * a[6] + w1 * b[6] + w2 * c[6], w0 * a[7] + w1 * b[7] + w2 * c[7]);
        *(uint4*)(Ya + (size_t)tok * 512 + h * 64 + ch * 8) = wv;
    }
}
constexpr int C_ROWS = 704;
__device__ __forceinline__ void mixC_mfma_unit(const bf16* Z, bf16* Yc, const float* rpb, LAS unsigned char* lds, int u, int S, int tid) {
    const int h = u & 7, rp = u >> 3, rps = S >> 8, sq = rp / rps, np = rp - sq * rps, seq0 = sq * S, rows = S >> 6;
    const int lane = tid & 63, w = tid >> 6, n = lane & 15, q = lane >> 4;
    int rb = 4 * np - 4; rb = rb < 0 ? 0 : (rb > rows - 11 ? rows - 11 : rb);
    const bf16* zk = Z + (size_t)seq0 * NZ + 6656 + h * 64;
    __syncthreads();
    {
        constexpr int NIT = C_ROWS * 8 / NTHR;
        pg8::u32x4 buf[NIT];
#pragma unroll
        for (int i = 0; i < NIT; ++i) { const int c = tid + i * NTHR, row = c >> 3, ch = c & 7; buf[i] = *(const pg8::u32x4*)(zk + (size_t)(rb * 64 + row) * NZ + 512 + ch * 8); }
#pragma unroll
        for (int i = 0; i < NIT; ++i) { const int c = tid + i * NTHR, row = c >> 3, ch = c & 7; *(LAS pg8::u32x4*)(lds + row * KPITCH + ch * 16) = buf[i]; }
        if (tid < 15 * 31) ((LAS float*)(lds + C_ROWS * KPITCH))[tid] = rpb[h * 15 * 31 + tid];
    }
    __syncthreads();
#pragma unroll
    for (int qt = 0; qt < 2; ++qt) {
    const int qr = 4 * np + 2 * qt + (w >> 2), cb = w & 3, qc = cb * 16 + n;
    int rs = qr - 4; rs = rs < 0 ? 0 : (rs > rows - 8 ? rows - 8 : rs);
    int cbs = cb * 16 - 8; cbs = cbs < 0 ? 0 : (cbs > 32 ? 32 : cbs);
    int cs = qc - 8; cs = cs < 0 ? 0 : (cs > 48 ? 48 : cs);
    const int tokc = seq0 + qr * 64 + qc;
    const bf16* qp = Z + (size_t)tokc * NZ + 6144 + h * 64;
    const bf16x8_t qf0 = *(const bf16x8_t*)(qp + 8 * q), qf1 = *(const bf16x8_t*)(qp + 32 + 8 * q);
    f32x4 s[16];
#pragma unroll
    for (int hf = 0; hf < 2; ++hf) {
        bf16x8_t kf[8][2];
#pragma unroll
        for (int tt = 0; tt < 8; ++tt) { const int t = 8 * hf + tt;
            const bf16* kp = zk + (size_t)((rs + (t >> 1)) * 64 + cbs + (t & 1) * 16 + n) * NZ + 8 * q;
            kf[tt][0] = *(const bf16x8_t*)kp; kf[tt][1] = *(const bf16x8_t*)(kp + 32); }
#pragma unroll
        for (int tt = 0; tt < 8; ++tt) {
            f32x4 a = {0.f, 0.f, 0.f, 0.f};
            a = __builtin_amdgcn_mfma_f32_16x16x32_bf16(kf[tt][0], qf0, a, 0, 0, 0);
            s[8 * hf + tt] = __builtin_amdgcn_mfma_f32_16x16x32_bf16(kf[tt][1], qf1, a, 0, 0, 0);
        }
        __builtin_amdgcn_sched_barrier(0);
    }
    const LAS float* rbp = (const LAS float*)(lds + C_ROWS * KPITCH);
    float m = -1e30f;
#pragma unroll
    for (int t = 0; t < 16; ++t)
#pragma unroll
        for (int j = 0; j < 4; ++j) {
            const int kr = rs + (t >> 1), kc = cbs + (t & 1) * 16 + 4 * q + j;
            const bool valid = (kc >= cs) && (kc < cs + 16);
            int dc = kc - qc + 15; dc = dc < 0 ? 0 : (dc > 30 ? 30 : dc);
            const float sc = s[t][j] * 0.125f + rbp[(kr - qr + 7) * 31 + dc];
            s[t][j] = valid ? sc : -1e30f; m = fmaxf(m, s[t][j]);
        }
    m = fmaxf(m, __shfl_xor(m, 16)); m = fmaxf(m, __shfl_xor(m, 32));
    float l = 0.f;
#pragma unroll
    for (int t = 0; t < 16; ++t)
#pragma unroll
        for (int j = 0; j < 4; ++j) { const float pe = __expf(s[t][j] - m); s[t][j] = pe; l += pe; }
    l += __shfl_xor(l, 16); l += __shfl_xor(l, 32);
    f32x4 o[4];
#pragma unroll
    for (int dt = 0; dt < 4; ++dt) o[dt] = (f32x4){0.f, 0.f, 0.f, 0.f};
    LAS unsigned char* vb = lds + ((rs - rb) * 64 + cbs + 4 * q + ((lane >> 2) & 3)) * KPITCH + 8 * (lane & 3);
#pragma unroll
    for (int G = 0; G < 8; ++G) {
        const bf16x8_t pb = packp(s[2 * G], s[2 * G + 1]);
#pragma unroll
        for (int dt = 0; dt < 4; ++dt) {
            const s16x4_t lo = trread(vb + (64 * G) * KPITCH + dt * 32), hi = trread(vb + (64 * G + 16) * KPITCH + dt * 32);
            o[dt] = __builtin_amdgcn_mfma_f32_16x16x32_bf16(cat4(lo, hi), pb, o[dt], 0, 0, 0);
        }
    }
    const float inv = 1.f / l;
    bf16* yp = Yc + (size_t)tokc * 512 + h * 64;
#pragma unroll
    for (int dt = 0; dt < 4; ++dt) { uint2 wv; wv.x = pg8::cvt_pk_bf16(o[dt][0] * inv, o[dt][1] * inv); wv.y = pg8::cvt_pk_bf16(o[dt][2] * inv, o[dt][3] * inv);
        *(uint2*)(yp + dt * 16 + 4 * q) = wv; }
    }
}

constexpr int VPITCH = 288;
constexpr int B1_V = 0, B1_KF = 128 * VPITCH, B1_KB = B1_KF + 128 * KPITCH;
__device__ __forceinline__ void mixB1_mfma_unit(const bf16* Z, float* ST, LAS unsigned char* lds, int gn, int hb, float lgf, float lgb, int tid) {
    const int lane = tid & 63, w = tid >> 6, n = lane & 15, q = lane >> 4;
    const bf16* zb = Z + (size_t)gn * 128 * NZ;
    __syncthreads();
    {
        pg8::u32x4 vbuf[4]; uint4 kbuf[2];
#pragma unroll
        for (int i = 0; i < 4; ++i) { const int c = tid + i * NTHR, row = c >> 4, ch = c & 15; vbuf[i] = *(const pg8::u32x4*)(zb + (size_t)row * NZ + 5120 + hb * 128 + ch * 8); }
#pragma unroll
        for (int i = 0; i < 2; ++i) { const int c = tid + i * NTHR, row = c >> 3, ch = c & 7; kbuf[i] = *(const uint4*)(zb + (size_t)row * NZ + 4864 + hb * 64 + ch * 8); }
#pragma unroll
        for (int i = 0; i < 4; ++i) { const int c = tid + i * NTHR, row = c >> 4, ch = c & 15; *(LAS pg8::u32x4*)(lds + B1_V + row * VPITCH + ch * 16) = vbuf[i]; }
#pragma unroll
        for (int i = 0; i < 2; ++i) { const int c = tid + i * NTHR, row = c >> 3, ch = c & 7;
            float k[8]; unpack8(kbuf[i], k);
            const float wf = 0.125f * __expf(lgf * (float)(127 - row)), wb = 0.125f * __expf(lgb * (float)row);
            pg8::u32x4 a, b;
            a.x = pg8::cvt_pk_bf16(k[0] * wf, k[1] * wf); a.y = pg8::cvt_pk_bf16(k[2] * wf, k[3] * wf); a.z = pg8::cvt_pk_bf16(k[4] * wf, k[5] * wf); a.w = pg8::cvt_pk_bf16(k[6] * wf, k[7] * wf);
            b.x = pg8::cvt_pk_bf16(k[0] * wb, k[1] * wb); b.y = pg8::cvt_pk_bf16(k[2] * wb, k[3] * wb); b.z = pg8::cvt_pk_bf16(k[4] * wb, k[5] * wb); b.w = pg8::cvt_pk_bf16(k[6] * wb, k[7] * wb);
            *(LAS pg8::u32x4*)(lds + B1_KF + row * KPITCH + ch * 16) = a; *(LAS pg8::u32x4*)(lds + B1_KB + row * KPITCH + ch * 16) = b; }
    }
    __syncthreads();
    f32x4 af[4], ab[4];
#pragma unroll
    for (int dt = 0; dt < 4; ++dt) { af[dt] = (f32x4){0.f, 0.f, 0.f, 0.f}; ab[dt] = (f32x4){0.f, 0.f, 0.f, 0.f}; }
    const int rsel = 4 * q + ((lane >> 2) & 3), csel = 8 * (lane & 3);
#pragma unroll
    for (int js = 0; js < 4; ++js) {
        LAS unsigned char* vp = lds + B1_V + (32 * js + rsel) * VPITCH + w * 32 + csel;
        const bf16x8_t va = cat4(trread(vp), trread(vp + 16 * VPITCH));
#pragma unroll
        for (int dt = 0; dt < 4; ++dt) {
            LAS unsigned char* kf = lds + B1_KF + (32 * js + rsel) * KPITCH + dt * 32 + csel;
            LAS unsigned char* kb = lds + B1_KB + (32 * js + rsel) * KPITCH + dt * 32 + csel;
            af[dt] = __builtin_amdgcn_mfma_f32_16x16x32_bf16(va, cat4(trread(kf), trread(kf + 16 * KPITCH)), af[dt], 0, 0, 0);
            ab[dt] = __builtin_amdgcn_mfma_f32_16x16x32_bf16(va, cat4(trread(kb), trread(kb + 16 * KPITCH)), ab[dt], 0, 0, 0);
        }
    }
    float* pf = ST + ((size_t)(0 * 4 + hb) * 128 + gn) * 8192 + 16 * w + 4 * q;
    float* pb = ST + ((size_t)(1 * 4 + hb) * 128 + gn) * 8192 + 16 * w + 4 * q;
#pragma unroll
    for (int dt = 0; dt < 4; ++dt) { *(f32x4*)(pf + (dt * 16 + n) * 128) = af[dt]; *(f32x4*)(pb + (dt * 16 + n) * 128) = ab[dt]; }
}
constexpr int B3_K = 0, B3_V = 128 * KPITCH, B3_SF = B3_V + 128 * VPITCH, B3_SB = B3_SF + 64 * VPITCH;
__device__ __forceinline__ void mixB3_mfma_unit(const bf16* Z, const float* ST, bf16* Yb, LAS unsigned char* lds, int gn, int hb, float lgf, float lgb, int tid) {
    const int lane = tid & 63, w = tid >> 6, n = lane & 15, q = lane >> 4;
    const bf16* zb = Z + (size_t)gn * 128 * NZ;
    const float* Sf = ST + ((size_t)(0 * 4 + hb) * 128 + gn) * 8192;
    const float* Sb = ST + ((size_t)(1 * 4 + hb) * 128 + gn) * 8192;
    __syncthreads();
    {
        pg8::u32x4 kbuf[2], vbuf[4]; f32x4 sbuf[4][2];
#pragma unroll
        for (int i = 0; i < 2; ++i) { const int c = tid + i * NTHR, row = c >> 3, ch = c & 7; kbuf[i] = *(const pg8::u32x4*)(zb + (size_t)row * NZ + 4864 + hb * 64 + ch * 8); }
#pragma unroll
        for (int i = 0; i < 4; ++i) { const int c = tid + i * NTHR, row = c >> 4, ch = c & 15; vbuf[i] = *(const pg8::u32x4*)(zb + (size_t)row * NZ + 5120 + hb * 128 + ch * 8); }
#pragma unroll
        for (int i = 0; i < 4; ++i) { const int c = tid + i * NTHR, dir = c >> 10, cc = c & 1023, row = cc >> 4, ch = cc & 15;
            const float* sp = (dir ? Sb : Sf) + row * 128 + ch * 8; sbuf[i][0] = *(const f32x4*)sp; sbuf[i][1] = *(const f32x4*)(sp + 4); }
#pragma unroll
        for (int i = 0; i < 2; ++i) { const int c = tid + i * NTHR, row = c >> 3, ch = c & 7; *(LAS pg8::u32x4*)(lds + B3_K + row * KPITCH + ch * 16) = kbuf[i]; }
#pragma unroll
        for (int i = 0; i < 4; ++i) { const int c = tid + i * NTHR, row = c >> 4, ch = c & 15; *(LAS pg8::u32x4*)(lds + B3_V + row * VPITCH + ch * 16) = vbuf[i]; }
#pragma unroll
        for (int i = 0; i < 4; ++i) { const int c = tid + i * NTHR, dir = c >> 10, cc = c & 1023, row = cc >> 4, ch = cc & 15;
            const f32x4 x0 = sbuf[i][0], x1 = sbuf[i][1];
            pg8::u32x4 a; a.x = pg8::cvt_pk_bf16(x0[0], x0[1]); a.y = pg8::cvt_pk_bf16(x0[2], x0[3]); a.z = pg8::cvt_pk_bf16(x1[0], x1[1]); a.w = pg8::cvt_pk_bf16(x1[2], x1[3]);
            *(LAS pg8::u32x4*)(lds + (dir ? B3_SB : B3_SF) + row * VPITCH + ch * 16) = a; }
    }
    __syncthreads();
    const int i = 16 * w + n, tokc = gn * 128 + i;
    const bf16* qp = Z + (size_t)tokc * NZ + 4608 + hb * 64;
    const int rsel = 4 * q + ((lane >> 2) & 3), csel = 8 * (lane & 3);
    f32x4 o[8];
    {
        const uint2 a0 = *(const uint2*)(qp + 4 * q), a1 = *(const uint2*)(qp + 16 + 4 * q), a2 = *(const uint2*)(qp + 32 + 4 * q), a3 = *(const uint2*)(qp + 48 + 4 * q);
        const bf16x8_t qc0 = __builtin_bit_cast(bf16x8_t, (uint4){a0.x, a0.y, a1.x, a1.y}), qc1 = __builtin_bit_cast(bf16x8_t, (uint4){a2.x, a2.y, a3.x, a3.y});
        const float cf = __expf(lgf * (float)(i + 1)), cb = __expf(lgb * (float)(128 - i));
#pragma unroll
        for (int et = 0; et < 8; ++et) {
            LAS unsigned char* sf = lds + B3_SF + rsel * VPITCH + et * 32 + csel;
            LAS unsigned char* sb = lds + B3_SB + rsel * VPITCH + et * 32 + csel;
            f32x4 f = {0.f, 0.f, 0.f, 0.f}, b = {0.f, 0.f, 0.f, 0.f};
            f = __builtin_amdgcn_mfma_f32_16x16x32_bf16(cat4(trread(sf), trread(sf + 16 * VPITCH)), qc0, f, 0, 0, 0);
            f = __builtin_amdgcn_mfma_f32_16x16x32_bf16(cat4(trread(sf + 32 * VPITCH), trread(sf + 48 * VPITCH)), qc1, f, 0, 0, 0);
            b = __builtin_amdgcn_mfma_f32_16x16x32_bf16(cat4(trread(sb), trread(sb + 16 * VPITCH)), qc0, b, 0, 0, 0);
            b = __builtin_amdgcn_mfma_f32_16x16x32_bf16(cat4(trread(sb + 32 * VPITCH), trread(sb + 48 * VPITCH)), qc1, b, 0, 0, 0);
            o[et] = f * cf + b * cb;
        }
    }
    {
        const bf16x8_t qf0 = *(const bf16x8_t*)(qp + 8 * q), qf1 = *(const bf16x8_t*)(qp + 32 + 8 * q);
        f32x4 s[8];
#pragma unroll
        for (int t = 0; t < 8; ++t) {
            LAS unsigned char* kp = lds + B3_K + (16 * t + n) * KPITCH + q * 16;
            f32x4 a = {0.f, 0.f, 0.f, 0.f};
            a = __builtin_amdgcn_mfma_f32_16x16x32_bf16(*(LAS bf16x8_t*)kp, qf0, a, 0, 0, 0);
            a = __builtin_amdgcn_mfma_f32_16x16x32_bf16(*(LAS bf16x8_t*)(kp + 64), qf1, a, 0, 0, 0);
#pragma unroll
            for (int j = 0; j < 4; ++j) { const int jj = 16 * t + 4 * q + j; const float dcy = (jj <= i) ? __expf(lgf * (float)(i - jj)) : __expf(lgb * (float)(jj - i)); a[j] = a[j] * 0.125f * dcy; }
            s[t] = a;
        }
#pragma unroll
        for (int G = 0; G < 4; ++G) {
            const bf16x8_t pb = packp(s[2 * G], s[2 * G + 1]);
#pragma unroll
            for (int et = 0; et < 8; ++et) {
                LAS unsigned char* vp = lds + B3_V + (32 * G + rsel) * VPITCH + et * 32 + csel;
                o[et] = __builtin_amdgcn_mfma_f32_16x16x32_bf16(cat4(trread(vp), trread(vp + 16 * VPITCH)), pb, o[et], 0, 0, 0);
            }
        }
    }
    float s1 = 0.f;
#pragma unroll
    for (int et = 0; et < 8; ++et) s1 += (o[et][0] + o[et][1]) + (o[et][2] + o[et][3]);
    s1 += __shfl_xor(s1, 16); s1 += __shfl_xor(s1, 32);
    const float mu = s1 * (1.f / 128.f);
    float s2 = 0.f;
#pragma unroll
    for (int et = 0; et < 8; ++et) { o[et] = o[et] - mu; s2 += (o[et][0] * o[et][0] + o[et][1] * o[et][1]) + (o[et][2] * o[et][2] + o[et][3] * o[et][3]); }
    s2 += __shfl_xor(s2, 16); s2 += __shfl_xor(s2, 32);
    const float rstd = 1.f / sqrtf(s2 * (1.f / 128.f) + GN_EPS);
    const bf16* gp = Z + (size_t)tokc * NZ + 5632 + hb * 128 + 4 * q;
    bf16* yp = Yb + (size_t)tokc * 512 + hb * 128 + 4 * q;
#pragma unroll
    for (int et = 0; et < 8; ++et) {
        const uint2 gw = *(const uint2*)(gp + et * 16);
        const float g0 = pg8::bflo(gw.x), g1 = pg8::bfhi(gw.x), g2 = pg8::bflo(gw.y), g3 = pg8::bfhi(gw.y);
        uint2 wv; wv.x = pg8::cvt_pk_bf16(o[et][0] * rstd * g0 * pg8::sigmoidf_(g0), o[et][1] * rstd * g1 * pg8::sigmoidf_(g1));
        wv.y = pg8::cvt_pk_bf16(o[et][2] * rstd * g2 * pg8::sigmoidf_(g2), o[et][3] * rstd * g3 * pg8::sigmoidf_(g3));
        *(uint2*)(yp + et * 16) = wv;
    }
}

#define RLX_AGENT __ATOMIC_RELAXED, __HIP_MEMORY_SCOPE_AGENT
#define XB_TMO      128
#define XB_XCNT(j)  (256  + 64 * (j))
#define XB_XSUB(j)  (1280 + 64 * (j))
#define XB_XGEN(j)  (2304 + 64 * (j))
#define XB_TOP      3328
#define XB_TOPGEN   3392
#define XCD_BAR_WORDS 3456
#define XB_SPIN_CAP (1u << 18)

__device__ __forceinline__ unsigned xb_ld(unsigned* p)              { return __hip_atomic_load(p, __ATOMIC_RELAXED, __HIP_MEMORY_SCOPE_AGENT); }
__device__ __forceinline__ unsigned xb_add(unsigned* p, unsigned v) { return __hip_atomic_fetch_add(p, v, __ATOMIC_RELAXED, __HIP_MEMORY_SCOPE_AGENT); }
__device__ __forceinline__ unsigned xb_xcc_id() { return (unsigned)__builtin_amdgcn_s_getreg((3 << 11) | 20) & 0xFu; }
#define XB_SPIN(cond, bar) do { unsigned _sp = 0; while (cond) { __builtin_amdgcn_s_sleep(1); \
    if ((++_sp & 255u) == 0u) { if (xb_ld(&(bar)[XB_TMO])) break; if (_sp > XB_SPIN_CAP) { atomicAdd(&(bar)[XB_TMO], 1u); break; } } } } while (0)

struct XcdBarrier {
    unsigned* bar; unsigned x;
    volatile LAS unsigned* st;
};

__device__ __forceinline__ XcdBarrier xcd_barrier_post(unsigned* bar, volatile LAS unsigned* st) {
    XcdBarrier b; b.bar = bar; b.x = xb_xcc_id(); b.st = st;
    if (threadIdx.x == 0) (void)xb_add(&bar[XB_XCNT(b.x)], 1u);
    return b;
}
__device__ __forceinline__ void xcd_barrier_complete(unsigned* bar, unsigned x, unsigned& nloc, unsigned& nx) {
    const unsigned G = gridDim.x * gridDim.y * gridDim.z;
    unsigned sum, cnt, mine, sp = 0u;
    for (;;) {
        sum = 0u; cnt = 0u; mine = 0u;
#pragma unroll
        for (unsigned j = 0; j < 16; ++j) { const unsigned c = xb_ld(&bar[XB_XCNT(j)]); sum += c; cnt += (c > 0u) ? 1u : 0u; mine = (j == x) ? c : mine; }
        if (sum == G) break;
        __builtin_amdgcn_s_sleep(1);
        if ((++sp & 255u) == 0u) { if (xb_ld(&bar[XB_TMO])) break; if (sp > XB_SPIN_CAP) { atomicAdd(&bar[XB_TMO], 1u); break; } }
    }
    nloc = mine > 0u ? mine : 1u; nx = cnt > 0u ? cnt : 1u;
}

__device__ __forceinline__ void xcd_barrier(const XcdBarrier& b) {
    asm volatile("s_waitcnt vmcnt(0)" ::: "memory");
    __syncthreads();
    if (threadIdx.x == 0) {
        unsigned* bar = b.bar;
        __builtin_amdgcn_s_waitcnt(0);
        unsigned nloc = b.st[0], nx = b.st[1];
        if (nloc == 0u) { xcd_barrier_complete(bar, b.x, nloc, nx); b.st[0] = nloc; b.st[1] = nx; }
        const unsigned old = xb_add(&bar[XB_XSUB(b.x)], 1u);
        const unsigned gen = old / nloc;
        if (old + 1u == (gen + 1u) * nloc) {
            __builtin_amdgcn_fence(__ATOMIC_RELEASE, "agent");
            asm volatile("s_waitcnt vmcnt(0)" ::: "memory");
            const unsigned og = xb_add(&bar[XB_TOP], 1u);
            const unsigned tg = og / nx;
            if (og + 1u == (tg + 1u) * nx) xb_add(&bar[XB_TOPGEN], 1u);
            else XB_SPIN(xb_ld(&bar[XB_TOPGEN]) == tg, bar);
            __builtin_amdgcn_fence(__ATOMIC_ACQUIRE, "agent");
            xb_add(&bar[XB_XGEN(b.x)], 1u);
            asm volatile("s_waitcnt vmcnt(0)" ::: "memory");
        } else {
            XB_SPIN(xb_ld(&bar[XB_XGEN(b.x)]) == gen, bar);
            __builtin_amdgcn_fence(__ATOMIC_ACQUIRE, "agent");
            asm volatile("s_waitcnt vmcnt(0)" ::: "memory");
        }
    }
    __syncthreads();
}

__device__ __forceinline__ float log_sigmoid_(float x) { return -log1pf(__expf(-x)); }
#ifndef PHMASK
#define PHMASK 0xFFFF
#endif
constexpr int NPHASE = 17;
__global__ void __launch_bounds__(NTHR, 2) fwd_megakernel(Params p) {
    extern __shared__ __attribute__((aligned(16))) unsigned char lds_raw[];
    cg::grid_group grid = cg::this_grid();
    LAS unsigned char* lds = (LAS unsigned char*)lds_raw;
    const int G = gridDim.x, bx = blockIdx.x;
    unsigned char* ws = p.ws;
    volatile LAS unsigned* bst = (volatile LAS unsigned*)(lds + 131072);
    if (threadIdx.x < 4) bst[threadIdx.x] = 0u;
    __syncthreads();
    if (ws == nullptr) grid.sync();
    const XcdBarrier xbar = xcd_barrier_post((unsigned*)ws, bst);

#pragma unroll 1
    for (int L = 0; L < DEPTH; ++L) {
        convert_weights(p, L, lds, G);
        xcd_barrier(xbar);
#pragma unroll 1
        for (int Pi = 0; Pi < 2; ++Pi) {
            const int P = (L & 1) ? 1 - Pi : Pi;
#pragma unroll 1
            for (int ph = ((L & 1) && Pi == 0) ? 1 : 0; ph < NPHASE; ++ph) {
                const int sub = ph < 3 ? ph : (ph < 15 ? 3 + (ph - 3) % 6 : ph - 6);
                const int ci = (ph >= 9 && ph < 15) ? 1 : 0;
                bf16* WB = (bf16*)(ws + WS_W); bf16* XBp = (bf16*)(ws + WS_XB); bf16* XBc = XBp + (size_t)ci * MC * D;
                bf16* Zb = (bf16*)(ws + WS_Z); bf16* Hb = (bf16*)(ws + WS_Z); bf16* MG = (bf16*)(ws + WS_Z);
                float* PART = (float*)(ws + WS_PART); bf16* GT = (bf16*)(ws + WS_G); bf16* Y = (bf16*)(ws + WS_Y); float* ST = (float*)XBc; float* LSEb = (float*)(ws + WS_LSE);
                float* EXb = (float*)(ws + WS_Y);
                unsigned* CNT = (unsigned*)(ws + WS_CNT);
                float* Xp = p.out + (size_t)P * 2 * MC * D; float* Xc = Xp + (size_t)ci * MC * D;
                const float* xinp = p.in[P];
                const int S = (P == 0) ? 8192 : 16384, nseq = MC / S;
                const bool isgemm = (sub == 1 || sub == 2 || sub == 3 || sub == 7 || sub == 8 || sub == 9 || sub == 10);
                if (isgemm) {
                    pg8::Gemm g; pg8::Sched So;
                    typedef unsigned long long u64;
                    u64 ep[10]; int mode = 0;
#pragma unroll
                    for (int i = 0; i < 10; ++i) ep[i] = 0;
                    if (sub == 1 || sub == 9) { g = pg8::Gemm{XBp, WB + (sub == 1 ? WO_W1C : WO_W2C), 2 * MC, 2 * FF, D}; So.init(2 * MC, 2 * FF, 1, G, bx, 4); mode = 0; ep[1] = (u64)Hb; }
                    else if (sub == 2) { g = pg8::Gemm{Hb, WB + WO_W1D, 2 * MC, D, FF}; So.init(2 * MC, D, 1, G, bx); mode = 1;
                        ep[1] = (u64)(L == 0 ? xinp : Xp); ep[2] = (u64)Xp; ep[3] = (u64)XBp; ep[4] = (u64)EXb; ep[5] = (u64)(p.in[5] + L * D); ep[6] = (u64)(p.in[6] + L * D); ep[7] = (u64)CNT;
                        ep[8] = (u64)__float_as_uint(ALPHA) | ((u64)__float_as_uint(0.5f) << 32); ep[9] = (u64)(unsigned)(4 * (3 * L + 1)) | ((u64)(unsigned)(P * 128) << 32); }
                    else if (sub == 10) { g = pg8::Gemm{Hb, WB + WO_W2D, 2 * MC, D, FF}; So.init(2 * MC, D, 1, G, bx); mode = 1;
                        ep[1] = (u64)Xp; ep[2] = (u64)Xp; ep[3] = (u64)XBp; ep[4] = (u64)EXb; ep[5] = (u64)(p.in[20] + L * D); ep[6] = (u64)(p.in[21] + L * D); ep[7] = (u64)CNT;
                        ep[8] = (u64)__float_as_uint(ALPHA) | ((u64)__float_as_uint(0.5f) << 32); ep[9] = (u64)(unsigned)(4 * (3 * L + 3)) | ((u64)(unsigned)(P * 128) << 32); }
                    else if (sub == 3) { g = pg8::Gemm{XBc, WB + WO_WIN, MC, DIN, D}; So.init(MC, DIN, 1, G, bx, 4); mode = 2; ep[1] = (u64)Zb; ep[2] = (u64)GT; }
                    else if (sub == 7) { g = pg8::Gemm{Y, WB + WO_PBR, 3 * MC, 3 * D, 512}; So.init(MC, D, 3, G, bx); mode = 3; ep[1] = (u64)GT; ep[2] = (u64)PART; ep[3] = (u64)MG; }
                    else { g = pg8::Gemm{MG, WB + WO_WOUT, MC, D, D}; So.init(MC, D, 1, G, bx); mode = 1;
                        ep[1] = (u64)Xc; ep[2] = (u64)Xc; ep[3] = (u64)XBc; ep[4] = (u64)EXb; ep[5] = (u64)(p.in[15] + L * D); ep[6] = (u64)(p.in[16] + L * D); ep[7] = (u64)CNT;
                        ep[8] = (u64)__float_as_uint(ALPHA) | ((u64)__float_as_uint(1.0f) << 32); ep[9] = (u64)(unsigned)(4 * (3 * L + 2)) | ((u64)(unsigned)(P * 128 + ci * 64) << 32); }
                    ep[0] = (u64)(unsigned)mode;
                    if (threadIdx.x == 0) {
                        LAS u64* epl = (LAS u64*)(lds + 131072 + 64 + 2240);
#pragma unroll
                        for (int i = 0; i < 10; ++i) epl[i] = ep[i];
                    }
                    __syncthreads();
                    if (mode == 1) pg8::gemm_phase(lds, g, So, pg8::EpiAll<1>{}); else if (mode == 3) pg8::gemm_phase(lds, g, So, pg8::EpiAll<2>{}); else pg8::gemm_phase(lds, g, So, pg8::EpiAll<0>{});
                } else {
                    int tid = threadIdx.x; asm volatile("" : "+v"(tid));
                    const int gtid = bx * NTHR + tid, gthreads = G * NTHR;
                    if (sub == 0) {
                        convert_rows(L == 0 ? xinp : Xp, XBp, 2 * MC, gtid, gthreads);
                    } else if (sub == 4) {
                        constexpr int NB1 = 128 * 4, NA = 3 * 512, NC = 64 * 8;
                        const float* rpb = p.in[10] + L * 8 * 15 * 31;
                        int it = bx;
#pragma unroll 1
                        for (; it < NB1; it += G) { int t2 = tid; asm volatile("" : "+v"(t2)); const int gn = it >> 2, hb = it & 3;
                            mixB1_mfma_unit(Zb, ST, lds, gn, hb, log_sigmoid_(p.in[8][L * 4 + hb]), log_sigmoid_(p.in[9][L * 4 + hb]), t2); }
                        if (it < NB1 + NA) {
                            pg8::u32x4 abuf[A_NIT];
                            { int t2 = tid; asm volatile("" : "+v"(t2)); mixA_load(Zb, it - NB1, S, t2, abuf); }
#pragma unroll 1
                            for (; it < NB1 + NA; it += G) {
                                int t2 = tid; asm volatile("" : "+v"(t2));
                                __syncthreads(); mixA_store(lds, t2, abuf); __syncthreads();
                                if (it + G < NB1 + NA) mixA_load(Zb, it + G - NB1, S, t2, abuf);
                                mixA_compute(Zb, LSEb, lds, it - NB1, S, t2);
                            }
                        }
#pragma unroll 1
                        for (; it < NB1 + NA + NC; it += G) { int t2 = tid; asm volatile("" : "+v"(t2)); mixC_mfma_unit(Zb, Y + (size_t)2 * MC * 512, rpb, lds, it - NB1 - NA, S, t2); }
                    } else if (sub == 5) {
                        mixB2(ST, S, nseq, p.in[8] + L * 4, p.in[9] + L * 4, gtid, gthreads);
                    } else if (sub == 6) {
#pragma unroll 1
                        for (int it = bx; it < 128 * 4; it += G) { const int gn = it >> 2, hb = it & 3; int t2 = tid; asm volatile("" : "+v"(t2));
                            mixB3_mfma_unit(Zb, ST, Y + (size_t)MC * 512, lds, gn, hb, log_sigmoid_(p.in[8][L * 4 + hb]), log_sigmoid_(p.in[9][L * 4 + hb]), t2); }
                        mixA_merge(Zb, LSEb, Y, gtid, gthreads);
                    }
                }
                xcd_barrier(xbar);
            }
        }
    }
}

extern "C" void kernel_launch(void* const* d_in, const int* in_sizes, int n_in, void* d_out, int out_size, void* d_ws, size_t ws_size, hipStream_t stream) {
    static int grid = 0;
    if (grid == 0) {
        if (n_in != 22 || out_size != NTOK * D || ws_size < WS_END) { fprintf(stderr, "kernel_launch: unexpected shapes (n_in %d out %d ws %zu)\n", n_in, out_size, ws_size); grid = -1; return; }
        int dev = 0, cus = 0, per_cu = 0;
        hipGetDevice(&dev);
        hipDeviceGetAttribute(&cus, hipDeviceAttributeMultiprocessorCount, dev);
        hipFuncSetAttribute((const void*)fwd_megakernel, hipFuncAttributeMaxDynamicSharedMemorySize, LDS_BYTES);
        hipOccupancyMaxActiveBlocksPerMultiprocessor(&per_cu, (const void*)fwd_megakernel, NTHR, LDS_BYTES);
        if (per_cu < 1) { fprintf(stderr, "kernel_launch: occupancy query gives %d\n", per_cu); per_cu = 1; }
        (void)hipGetLastError();
        grid = cus * 1;
    }
    if (grid < 0) return;
    if (hipMemsetAsync(d_ws, 0, 32768, stream) != hipSuccess) { fprintf(stderr, "kernel_launch: memset of barrier words failed\n"); return; }
    Params p{};
    for (int i = 0; i < 22; ++i) p.in[i] = (const float*)d_in[i];
    p.out = (float*)d_out; p.ws = (unsigned char*)d_ws;
    void* args[] = {&p};
    hipError_t e = hipLaunchCooperativeKernel((const void*)fwd_megakernel, dim3(grid), dim3(NTHR), args, LDS_BYTES, stream);
    if (e != hipSuccess) fprintf(stderr, "cooperative launch failed: %s (grid %d)\n", hipGetErrorString(e), grid);
}
```

```cpp
#include <hip/hip_runtime.h>
#include <hip/hip_cooperative_groups.h>
#include <cstdio>
#include <cstdint>
namespace cg = cooperative_groups;

namespace pg8 {
#define PG8_LAS __attribute__((address_space(3)))
typedef unsigned short bf16_t;
typedef short bf16x8 __attribute__((ext_vector_type(8)));
typedef float f32x4 __attribute__((ext_vector_type(4)));
typedef unsigned u32x4 __attribute__((ext_vector_type(4)));
constexpr int BM = 256, BK = 64, HALF = 128, HTB = HALF * BK * 2, STAGE_BYTES = 8 * HTB, NXCD = 8, WGM = 8;

__host__ __device__ __forceinline__ int lds_byte(int r, int c) { const int st = (r >> 4) * 2 + (c >> 5), rr = r & 15, cc = c & 31, ob = rr * 64 + cc * 2; return st * 1024 + (ob ^ (((ob >> 9) & 1) << 5)); }
__host__ __device__ __forceinline__ void stage_rc(int b, int& R, int& C) { const int st = b / 1024, sb = b % 1024, swz = sb ^ (((sb >> 9) & 1) << 5); R = (st >> 1) * 16 + swz / 64; C = (st & 1) * 32 + (swz % 64) / 2; }
__host__ __device__ __forceinline__ int perm32(int rho) { const int n = rho >> 4, i = rho & 15; return 8 * (i >> 2) + 4 * n + (i & 3); }

struct Unit { int pm, pn; };
struct Gemm { const bf16_t* A; const bf16_t* Bt; int M, N, K; };

struct StaticOrder {
    int nM, nN, nwg, G, c, wgm;
    __host__ __device__ void init(int M, int N, int G_, int c_, int wgm_ = WGM) { nM = M / BM; nN = N / BM; nwg = nM * nN; G = G_; c = c_; wgm = wgm_; }
    __host__ __device__ bool next(int i, Unit& u) const {
        const long L = (long)i * G + c; if (L >= nwg) return false;
        int wgid = (int)L; { const int q = nwg / NXCD, r = nwg % NXCD, xcd = wgid % NXCD, off = wgid / NXCD; wgid = (xcd < r ? xcd * (q + 1) : r * (q + 1) + (xcd - r) * q) + off; }
        const int nig = wgm * nN, gid = wgid / nig, fm = gid * wgm, gsz = (nM - fm) < wgm ? (nM - fm) : wgm;
        u.pm = fm + ((wgid % nig) % gsz); u.pn = (wgid % nig) / gsz; return true;
    }
};
struct Sched {
    StaticOrder S0; int nbr, nMt, nNt;
    __device__ void init(int M, int N, int nbr_, int G_, int c_, int wgm_ = WGM) { S0.init(M, N, G_, c_, wgm_); nbr = nbr_; nMt = M / BM; nNt = N / BM; }
    __device__ bool next(int i, Unit& u) const {
        if (nbr == 1) return S0.next(i, u);
        Unit t; if (!S0.next(i / 3, t)) return false; const int b = i % 3; u.pm = b * nMt + t.pm; u.pn = b * nNt + t.pn; return true; }
    __device__ bool carry(int i) const { return nbr == 3 && (i % 3) != 2; }
};

__device__ __forceinline__ unsigned cvt_pk_bf16(float lo, float hi) { unsigned r; asm volatile("v_cvt_pk_bf16_f32 %0, %1, %2" : "=v"(r) : "v"(lo), "v"(hi)); return r; }
__device__ __forceinline__ float bflo(unsigned w) { return __uint_as_float(w << 16); }
__device__ __forceinline__ float bfhi(unsigned w) { return __uint_as_float(w & 0xffff0000u); }
__device__ __forceinline__ float sigmoidf_(float x) { return __builtin_amdgcn_rcpf(1.f + __expf(-x)); }

struct EpiSwiglu {
    static constexpr bool PERM = true;
    bf16_t* H; int ldh;
    __device__ __forceinline__ void operator()(const f32x4 (&acc)[2][2][4][2], const Unit& u, int wr, int wc, int fr, int fq) const {
        const int row0 = u.pm * BM + wr * 64 + fr, col0 = u.pn * HALF + wc * 32 + 8 * fq;
#pragma unroll
        for (int ai = 0; ai < 2; ++ai)
#pragma unroll
            for (int m = 0; m < 4; ++m) {
                f32x4 hv[2];
#pragma unroll
                for (int n = 0; n < 2; ++n) {
                    const f32x4 g = acc[ai][0][m][n], up = acc[ai][1][m][n];
                    const f32x4 t = g * (-1.44269504088896341f);
                    f32x4 d; d[0] = __builtin_amdgcn_exp2f(t[0]); d[1] = __builtin_amdgcn_exp2f(t[1]); d[2] = __builtin_amdgcn_exp2f(t[2]); d[3] = __builtin_amdgcn_exp2f(t[3]);
                    d = d + 1.0f;
                    f32x4 r; r[0] = __builtin_amdgcn_rcpf(d[0]); r[1] = __builtin_amdgcn_rcpf(d[1]); r[2] = __builtin_amdgcn_rcpf(d[2]); r[3] = __builtin_amdgcn_rcpf(d[3]);
                    hv[n] = (g * up) * r;
                }
                u32x4 w; w.x = cvt_pk_bf16(hv[0][0], hv[0][1]); w.y = cvt_pk_bf16(hv[0][2], hv[0][3]); w.z = cvt_pk_bf16(hv[1][0], hv[1][1]); w.w = cvt_pk_bf16(hv[1][2], hv[1][3]);
                *(u32x4*)(H + (size_t)(row0 + ai * HALF + m * 16) * ldh + col0) = w;
            }
    }
};
struct EpiResid {
    static constexpr bool PERM = true;
    const float* Xin; float* Xout; bf16_t* XB; float* EX; const float* gam; const float* bet; unsigned* cnt; unsigned target; int pbase; float alpha, s;
    __device__ __forceinline__ void operator()(f32x4 (&acc)[2][2][4][2], const Unit& u, int wr, int wc, int fr, int fq, PG8_LAS float* sl) const {
        const int tid = threadIdx.x;
        const int lr0 = wr * 64 + fr, col0 = u.pn * BM + wc * 32 + 8 * fq;
        PG8_LAS float* red = sl + 1008;
#pragma unroll
        for (int ai = 0; ai < 2; ++ai) {
            f32x4 xl[4][2][2];
#pragma unroll
            for (int m = 0; m < 4; ++m)
#pragma unroll
                for (int bj = 0; bj < 2; ++bj) {
                    const size_t off = (size_t)(u.pm * BM + lr0 + ai * HALF + m * 16) * 1024 + col0 + bj * HALF;
                    xl[m][bj][0] = *(const f32x4*)(Xin + off); xl[m][bj][1] = *(const f32x4*)(Xin + off + 4);
                }
#pragma unroll
            for (int m = 0; m < 4; ++m) {
                const int lr = lr0 + ai * HALF + m * 16;
                float rs = 0.f, rq = 0.f;
#pragma unroll
                for (int bj = 0; bj < 2; ++bj) {
                    const f32x4 x0 = xl[m][bj][0] * alpha + acc[ai][bj][m][0] * s, x1 = xl[m][bj][1] * alpha + acc[ai][bj][m][1] * s;
                    acc[ai][bj][m][0] = x0; acc[ai][bj][m][1] = x1;
                    rs += (x0[0] + x0[1]) + (x0[2] + x0[3]) + (x1[0] + x1[1]) + (x1[2] + x1[3]);
                    rq += (x0[0] * x0[0] + x0[1] * x0[1]) + (x0[2] * x0[2] + x0[3] * x0[3]) + (x1[0] * x1[0] + x1[1] * x1[1]) + (x1[2] * x1[2] + x1[3] * x1[3]);
                }
                rs += __shfl_xor(rs, 16); rs += __shfl_xor(rs, 32); rq += __shfl_xor(rq, 16); rq += __shfl_xor(rq, 32);
                if (fq == 0) { red[(wc * 256 + lr) * 2] = rs; red[(wc * 256 + lr) * 2 + 1] = rq; }
            }
            __builtin_amdgcn_sched_barrier(0);
        }
        asm volatile("s_waitcnt lgkmcnt(0)" ::: "memory"); __builtin_amdgcn_s_barrier();
        const int panel = pbase + u.pm;
        if (tid < 256) {
            float a = 0.f, b = 0.f;
#pragma unroll
            for (int k = 0; k < 4; ++k) { a += red[(k * 256 + tid) * 2]; b += red[(k * 256 + tid) * 2 + 1]; }
            float* ex = EX + ((size_t)(panel * 4 + u.pn) * 256 + tid) * 2;
            __hip_atomic_store(ex, a, __ATOMIC_RELAXED, __HIP_MEMORY_SCOPE_AGENT); __hip_atomic_store(ex + 1, b, __ATOMIC_RELAXED, __HIP_MEMORY_SCOPE_AGENT);
        }
        asm volatile("s_waitcnt vmcnt(0)" ::: "memory"); __builtin_amdgcn_s_barrier();
        if (tid == 0) {
            __hip_atomic_fetch_add(cnt + panel, 1u, __ATOMIC_RELAXED, __HIP_MEMORY_SCOPE_AGENT);
            unsigned sp = 0;
            while (__hip_atomic_load(cnt + panel, __ATOMIC_RELAXED, __HIP_MEMORY_SCOPE_AGENT) < target) { __builtin_amdgcn_s_sleep(1); if (++sp > (1u << 22)) break; }
        }
        __builtin_amdgcn_s_barrier();
        if (tid < 256) {
            float a = 0.f, b = 0.f;
#pragma unroll
            for (int k = 0; k < 4; ++k) { const float* ex = EX + ((size_t)(panel * 4 + k) * 256 + tid) * 2;
                a += __hip_atomic_load(ex, __ATOMIC_RELAXED, __HIP_MEMORY_SCOPE_AGENT); b += __hip_atomic_load(ex + 1, __ATOMIC_RELAXED, __HIP_MEMORY_SCOPE_AGENT); }
            const float mu = a * (1.f / 1024.f), var = fmaxf(b * (1.f / 1024.f) - mu * mu, 0.f);
            sl[2 * tid] = mu; sl[2 * tid + 1] = 1.f / sqrtf(var + 1e-5f);
        }
        asm volatile("s_waitcnt lgkmcnt(0)" ::: "memory"); __builtin_amdgcn_s_barrier();
#pragma unroll
        for (int bj = 0; bj < 2; ++bj) {
            const int col = col0 + bj * HALF;
            const f32x4 g0 = *(const f32x4*)(gam + col), g1 = *(const f32x4*)(gam + col + 4), b0 = *(const f32x4*)(bet + col), b1 = *(const f32x4*)(bet + col + 4);
#pragma unroll
            for (int ai = 0; ai < 2; ++ai)
#pragma unroll
                for (int m = 0; m < 4; ++m) {
                    const int lr = lr0 + ai * HALF + m * 16; const float mu = sl[2 * lr], rstd = sl[2 * lr + 1];
                    const size_t off = (size_t)(u.pm * BM + lr) * 1024 + col;
                    const f32x4 y0 = (acc[ai][bj][m][0] - mu) * rstd * g0 + b0, y1 = (acc[ai][bj][m][1] - mu) * rstd * g1 + b1;
                    *(f32x4*)(Xout + off) = y0; *(f32x4*)(Xout + off + 4) = y1;
                    u32x4 w; w.x = cvt_pk_bf16(y0[0], y0[1]); w.y = cvt_pk_bf16(y0[2], y0[3]); w.z = cvt_pk_bf16(y1[0], y1[1]); w.w = cvt_pk_bf16(y1[2], y1[3]);
                    *(u32x4*)(XB + off) = w;
                    __builtin_amdgcn_sched_barrier(0);
                }
        }
    }
};
struct EpiWin {
    static constexpr bool PERM = true;
    bf16_t* Z; bf16_t* Gt;
    __device__ __forceinline__ void operator()(const f32x4 (&acc)[2][2][4][2], const Unit& u, int wr, int wc, int fr, int fq) const {
        const int row0 = u.pm * BM + wr * 64 + fr; const bool isg = u.pn >= 30;
        bf16_t* base = isg ? Gt : Z; const int ld = isg ? 3072 : 7680; const int col0 = (isg ? (u.pn - 30) : u.pn) * BM + wc * 32 + 8 * fq;
#pragma unroll
        for (int ai = 0; ai < 2; ++ai)
#pragma unroll
            for (int m = 0; m < 4; ++m)
#pragma unroll
                for (int bj = 0; bj < 2; ++bj) {
                    f32x4 v0 = acc[ai][bj][m][0], v1 = acc[ai][bj][m][1];
                    if (isg) {
#pragma unroll
                        for (int j = 0; j < 4; ++j) { v0[j] = 1.f + __builtin_amdgcn_exp2f(v0[j] * -1.44269504088896341f); v1[j] = 1.f + __builtin_amdgcn_exp2f(v1[j] * -1.44269504088896341f); }
                    }
                    u32x4 w; w.x = cvt_pk_bf16(v0[0], v0[1]); w.y = cvt_pk_bf16(v0[2], v0[3]); w.z = cvt_pk_bf16(v1[0], v1[1]); w.w = cvt_pk_bf16(v1[2], v1[3]);
                    *(u32x4*)(base + (size_t)(row0 + ai * HALF + m * 16) * ld + col0 + bj * HALF) = w;
                }
    }
};
struct EpiBranch {
    static constexpr bool PERM = true;
    const bf16_t* Gt; bf16_t* Mg; int nMt;
    __device__ __forceinline__ void operator()(f32x4 (&acc)[2][2][4][2], const Unit& u, int wr, int wc, int fr, int fq) const {
        const int b = u.pm / nMt, pm = u.pm - b * nMt, pn = u.pn - b * 4;
        const int row0 = pm * BM + wr * 64 + fr, col0 = pn * BM + wc * 32 + 8 * fq;
#pragma unroll
        for (int ai = 0; ai < 2; ++ai) {
            u32x4 gw[4][2], gn[4][2];
#pragma unroll
            for (int m = 0; m < 4; ++m)
#pragma unroll
                for (int bj = 0; bj < 2; ++bj) {
                    const size_t row = (size_t)(row0 + ai * HALF + m * 16); const int col = col0 + bj * HALF;
                    gw[m][bj] = *(const u32x4*)(Gt + row * 3072 + b * 1024 + col);
                    if (b < 2) gn[m][bj] = *(const u32x4*)(Gt + row * 3072 + (b + 1) * 1024 + col); else gn[m][bj] = gw[m][bj];
                }
#pragma unroll
            for (int m = 0; m < 4; ++m)
#pragma unroll
                for (int bj = 0; bj < 2; ++bj) {
                    const u32x4 g = gw[m][bj], h = gn[m][bj];
                    f32x4 g0 = {bflo(g.x), bfhi(g.x), bflo(g.y), bfhi(g.y)}, g1 = {bflo(g.z), bfhi(g.z), bflo(g.w), bfhi(g.w)};
                    if (b < 2) {
                        const f32x4 h0 = {bflo(h.x), bfhi(h.x), bflo(h.y), bfhi(h.y)}, h1 = {bflo(h.z), bfhi(h.z), bflo(h.w), bfhi(h.w)};
#pragma unroll
                        for (int j = 0; j < 4; ++j) { g0[j] = h0[j] * __builtin_amdgcn_rcpf(g0[j]); g1[j] = h1[j] * __builtin_amdgcn_rcpf(g1[j]); }
                        acc[ai][bj][m][0] = acc[ai][bj][m][0] * g0; acc[ai][bj][m][1] = acc[ai][bj][m][1] * g1;
                    } else {
                        const size_t row = (size_t)(row0 + ai * HALF + m * 16); const int col = col0 + bj * HALF;
#pragma unroll
                        for (int j = 0; j < 4; ++j) { g0[j] = __builtin_amdgcn_rcpf(g0[j]); g1[j] = __builtin_amdgcn_rcpf(g1[j]); }
                        const f32x4 v0 = acc[ai][bj][m][0] * g0, v1 = acc[ai][bj][m][1] * g1;
                        u32x4 w; w.x = cvt_pk_bf16(v0[0], v0[1]); w.y = cvt_pk_bf16(v0[2], v0[3]); w.z = cvt_pk_bf16(v1[0], v1[1]); w.w = cvt_pk_bf16(v1[2], v1[3]);
                        *(u32x4*)(Mg + row * 1024 + col) = w;
                    }
                }
            __builtin_amdgcn_sched_barrier(0);
        }
    }
};

__device__ __forceinline__ unsigned long long ldsu64(PG8_LAS const unsigned long long* p) {
    const unsigned long long v = *p; const unsigned lo = __builtin_amdgcn_readfirstlane((unsigned)v), hi = __builtin_amdgcn_readfirstlane((unsigned)(v >> 32));
    return ((unsigned long long)hi << 32) | lo;
}
template <int KIND  > struct EpiAll {
    static constexpr bool PERM = true;
    __device__ __forceinline__ void operator()(f32x4 (&acc)[2][2][4][2], const Unit& u, int wr, int wc, int fr, int fq, PG8_LAS float* sl) const {
        asm volatile("" : "+v"(fr), "+v"(fq), "+s"(wr), "+s"(wc));
        PG8_LAS const unsigned long long* ep = (PG8_LAS const unsigned long long*)((PG8_LAS unsigned char*)sl + 2240);
        if constexpr (KIND == 1) { const unsigned long long as = ldsu64(ep + 8), tp = ldsu64(ep + 9);
            EpiResid e{(const float*)ldsu64(ep + 1), (float*)ldsu64(ep + 2), (bf16_t*)ldsu64(ep + 3), (float*)ldsu64(ep + 4), (const float*)ldsu64(ep + 5), (const float*)ldsu64(ep + 6),
                       (unsigned*)ldsu64(ep + 7), (unsigned)tp, (int)(unsigned)(tp >> 32), __uint_as_float((unsigned)as), __uint_as_float((unsigned)(as >> 32))}; e(acc, u, wr, wc, fr, fq, sl); }
        else if constexpr (KIND == 2) { EpiBranch e{(const bf16_t*)ldsu64(ep + 1), (bf16_t*)ldsu64(ep + 3), 64}; e(acc, u, wr, wc, fr, fq); }
        else {
            const unsigned long long s0 = ldsu64(ep); const int mode = (int)(unsigned)s0;
            if (mode == 0) { EpiSwiglu e{(bf16_t*)ldsu64(ep + 1), 2816}; e(acc, u, wr, wc, fr, fq); }
            else { EpiWin e{(bf16_t*)ldsu64(ep + 1), (bf16_t*)ldsu64(ep + 2)}; e(acc, u, wr, wc, fr, fq); }
        }
    }
};

template <class Epi, class Sched>
__device__ __forceinline__ void gemm_phase(PG8_LAS unsigned char* lds, const Gemm g, const Sched& S, const Epi& E) {
    int tid = threadIdx.x; asm volatile("" : "+v"(tid));
    const int wid = __builtin_amdgcn_readfirstlane(tid >> 6), lane = tid & 63, wr = wid >> 2, wc = wid & 3, fr = lane & 15, fq = lane >> 4;
    const int K = g.K, nt = K / BK;
    unsigned voffA[2], voffB[2];
#pragma unroll
    for (int i = 0; i < 2; ++i) { int R, C; stage_rc(tid * 16 + i * 8192, R, C); const int Rb = Epi::PERM ? ((R & ~31) + perm32(R & 31)) : R;
        voffA[i] = (unsigned)(R * K + C) * 2u; voffB[i] = (unsigned)(Rb * K + C) * 2u; }
    const size_t kstep = (size_t)(BK * 2);
    const size_t hstep = (size_t)HALF * K * 2;
    const size_t tstep = 2 * hstep;
    const unsigned ldsw = (unsigned)wid * 1024u;
    const int aoff = lds_byte(wr * 64 + fr, fq * 8), boff = lds_byte(wc * 32 + fr, fq * 8);
#define PG8_SA(b, h) (((b) * 2 + (h)) * HTB)
#define PG8_SB(b, h) ((4 + (b) * 2 + (h)) * HTB)
#define PG8_STAGE(bufoff, gbase, voff) do { _Pragma("unroll") for (int _i = 0; _i < 2; ++_i) \
        __builtin_amdgcn_global_load_lds((const unsigned*)((const char*)(gbase) + (voff)[_i]), (PG8_LAS unsigned*)(lds + (bufoff) + ldsw + _i * 8192), 16, 0, 0); } while (0)
#define PG8_LDA(dst, b, h) do { _Pragma("unroll") for (int m = 0; m < 4; ++m) _Pragma("unroll") for (int k = 0; k < 2; ++k) dst[m][k] = *(const PG8_LAS bf16x8*)(lds + PG8_SA(b, h) + aoff + m * 2048 + k * 1024); } while (0)
#define PG8_LDB(dst, b, h) do { _Pragma("unroll") for (int n = 0; n < 2; ++n) _Pragma("unroll") for (int k = 0; k < 2; ++k) dst[n][k] = *(const PG8_LAS bf16x8*)(lds + PG8_SB(b, h) + boff + n * 2048 + k * 1024); } while (0)
#define PG8_MMA(ai, bj, At, Bt) do { __builtin_amdgcn_s_setprio(1); _Pragma("unroll") for (int m = 0; m < 4; ++m) _Pragma("unroll") for (int n = 0; n < 2; ++n) _Pragma("unroll") for (int k = 0; k < 2; ++k) \
        acc[ai][bj][m][n] = __builtin_amdgcn_mfma_f32_16x16x32_bf16(Bt[n][k], At[m][k], acc[ai][bj][m][n], 0, 0, 0); __builtin_amdgcn_s_setprio(0); } while (0)
#define PG8_WAIT_V(n) asm volatile("s_waitcnt vmcnt(" #n ")" ::: "memory")
#define PG8_WAIT_L(n) asm volatile("s_waitcnt lgkmcnt(" #n ")" ::: "memory")
#define PG8_BAR __builtin_amdgcn_s_barrier()
#define PG8_SCHED __builtin_amdgcn_sched_barrier(0)
    Unit cur, nxt; int ui = 0;
    if (!S.next(0, cur)) return;
    f32x4 acc[2][2][4][2];
#pragma unroll
    for (int a = 0; a < 2; ++a)
#pragma unroll
        for (int b = 0; b < 2; ++b)
#pragma unroll
            for (int m = 0; m < 4; ++m)
#pragma unroll
                for (int n = 0; n < 2; ++n) acc[a][b][m][n] = (f32x4){0.f, 0.f, 0.f, 0.f};
    bf16x8 At[4][2], B0[2][2], B1[2][2];
    const char* cA = (const char*)g.A + (size_t)cur.pm * tstep; const char* cB = (const char*)g.Bt + (size_t)cur.pn * tstep;
    PG8_STAGE(PG8_SB(0, 0), cB, voffB); PG8_STAGE(PG8_SB(0, 1), cB + hstep, voffB); PG8_STAGE(PG8_SA(0, 0), cA, voffA); PG8_STAGE(PG8_SA(0, 1), cA + hstep, voffA);
    if (wr == 1) PG8_BAR;
    PG8_WAIT_V(2); PG8_BAR;
    PG8_STAGE(PG8_SB(1, 0), cB + kstep, voffB); PG8_STAGE(PG8_SA(1, 0), cA + kstep, voffA); PG8_STAGE(PG8_SB(1, 1), cB + hstep + kstep, voffB);
    PG8_WAIT_V(6); PG8_BAR;
    for (;;) {
        const bool has_next = S.next(ui + 1, nxt);
        const char* nA = has_next ? (const char*)g.A + (size_t)nxt.pm * tstep : cA; const char* nB = has_next ? (const char*)g.Bt + (size_t)nxt.pn * tstep : cB;
        for (int t = 0; t < nt; t += 2) {
            const bool last = (t == nt - 2);
            const char* a1 = cA + (size_t)(t + 1) * kstep;
            const char* a2 = last ? nA : cA + (size_t)(t + 2) * kstep; const char* b2 = last ? nB : cB + (size_t)(t + 2) * kstep;
            const char* a3 = a2 + kstep; const char* b3 = b2 + kstep;
            PG8_LDB(B0, 0, 0); PG8_LDB(B1, 0, 1); PG8_SCHED; PG8_LDA(At, 0, 0); PG8_STAGE(PG8_SA(1, 1), a1 + hstep, voffA);
            PG8_WAIT_V(8); PG8_WAIT_L(0); PG8_BAR; PG8_MMA(0, 0, At, B0); PG8_MMA(0, 1, At, B1); PG8_BAR; PG8_SCHED;
            PG8_LDA(At, 0, 1); PG8_STAGE(PG8_SB(0, 0), b2, voffB); PG8_STAGE(PG8_SB(0, 1), b2 + hstep, voffB); PG8_STAGE(PG8_SA(0, 0), a2, voffA);
            PG8_WAIT_V(8); PG8_WAIT_L(0); PG8_BAR; PG8_MMA(1, 0, At, B0); PG8_MMA(1, 1, At, B1); PG8_BAR; PG8_SCHED;
            PG8_LDB(B0, 1, 0); PG8_LDB(B1, 1, 1); PG8_SCHED; PG8_LDA(At, 1, 0); PG8_STAGE(PG8_SA(0, 1), a2 + hstep, voffA);
            PG8_WAIT_V(8); PG8_WAIT_L(0); PG8_BAR; PG8_MMA(0, 0, At, B0); PG8_MMA(0, 1, At, B1); PG8_BAR; PG8_SCHED;
            PG8_LDA(At, 1, 1); PG8_STAGE(PG8_SB(1, 0), b3, voffB); PG8_STAGE(PG8_SB(1, 1), b3 + hstep, voffB); PG8_STAGE(PG8_SA(1, 0), a3, voffA);
            PG8_WAIT_V(8); PG8_WAIT_L(0); PG8_BAR; PG8_MMA(1, 0, At, B0); PG8_MMA(1, 1, At, B1); PG8_BAR; PG8_SCHED;
        }
        if (wr == 0) PG8_BAR;
        E(acc, cur, wr, wc, fr, fq, (PG8_LAS float*)(lds + 131072 + 64));
        if (!has_next) break;
        if (!S.carry(ui))
#pragma unroll
        for (int a = 0; a < 2; ++a)
#pragma unroll
            for (int b = 0; b < 2; ++b)
#pragma unroll
                for (int m = 0; m < 4; ++m)
#pragma unroll
                    for (int n = 0; n < 2; ++n) acc[a][b][m][n] = (f32x4){0.f, 0.f, 0.f, 0.f};
        cur = nxt; cA = nA; cB = nB; ++ui;
        if (wr == 1) PG8_BAR;
    }
    PG8_WAIT_V(0);
    PG8_BAR;
#undef PG8_SA
#undef PG8_SB
#undef PG8_STAGE
#undef PG8_LDA
#undef PG8_LDB
#undef PG8_MMA
#undef PG8_WAIT_V
#undef PG8_WAIT_L
#undef PG8_BAR
#undef PG8_SCHED
}
}

typedef unsigned short bf16;
typedef float f32x4 __attribute__((ext_vector_type(4)));
#define LAS __attribute__((address_space(3)))
constexpr int D = 1024, FF = 2816, NZ = 7680, NGATE = 3072, DIN = 10752;
constexpr int NTOK = 65536, MC = 16384, NCHUNK = 4, DEPTH = 2;
constexpr int NWAVES = 8, NTHR = 512;
constexpr float ALPHA = 1.41421356237309515f;
constexpr float LN_EPS = 1e-5f, GN_EPS = 1e-5f;
constexpr size_t MiB = 1u << 20;
constexpr size_t WO_W1C = 0, WO_W1D = WO_W1C + (size_t)2 * FF * D, WO_WIN = WO_W1D + (size_t)D * FF, WO_PBR = WO_WIN + (size_t)DIN * D,
                 WO_WOUT = WO_PBR + (size_t)3 * D * 512, WO_W2C = WO_WOUT + (size_t)D * D, WO_W2D = WO_W2C + (size_t)2 * FF * D, WO_END = WO_W2D + (size_t)D * FF;
constexpr size_t WS_CNT = 16384;
constexpr size_t WS_W = 1 * MiB, WS_XB = 61 * MiB  , WS_Z = 125 * MiB, WS_PART = 157 * MiB, WS_G = 365 * MiB, WS_Y = 461 * MiB, WS_LSE = 509 * MiB, WS_END = 511 * MiB;
static_assert(WS_W + WO_END * 2 <= WS_XB && WS_XB + (size_t)2 * MC * D * 2 <= WS_Z, "weights / Xb fit");
static_assert(WS_Z + (size_t)MC * NZ * 2 <= WS_G && WS_Z + (size_t)2 * MC * FF * 2 <= WS_G && WS_PART + (size_t)MC * D * 4 <= WS_G && WS_Z + (size_t)MC * D * 2 <= WS_PART, "Z overlays (H of a pair, merged, partial)");
static_assert(WS_G + (size_t)MC * NGATE * 2 <= WS_Y && WS_Y + (size_t)3 * MC * 512 * 2 <= WS_LSE && (size_t)2 * 4 * 128 * 8192 * 4 <= (size_t)MC * D * 2 && WS_LSE + (size_t)3 * MC * 8 * 4 <= WS_END, "ws map");
constexpr int LDS_BYTES = 131072 + 16384;

struct Params { const float* in[22]; float* out; unsigned char* ws; };

__device__ __forceinline__ float bf2f(bf16 v) { return __uint_as_float(((unsigned)v) << 16); }
__device__ __forceinline__ unsigned f2bf(float f) { unsigned u = __builtin_bit_cast(unsigned, f); return (u + 0x7fffu + ((u >> 16) & 1u)) >> 16; }
__device__ __forceinline__ unsigned pk2(float lo, float hi) { return f2bf(lo) | (f2bf(hi) << 16); }
__device__ __forceinline__ void unpack8(const uint4 w, float* f) {
    f[0] = pg8::bflo(w.x); f[1] = pg8::bfhi(w.x); f[2] = pg8::bflo(w.y); f[3] = pg8::bfhi(w.y);
    f[4] = pg8::bflo(w.z); f[5] = pg8::bfhi(w.z); f[6] = pg8::bflo(w.w); f[7] = pg8::bfhi(w.w);
}
__device__ __forceinline__ float wave_sum(float v) {
#pragma unroll
    for (int o = 1; o < 64; o <<= 1) v += __shfl_xor(v, o);
    return v;
}

__device__ __forceinline__ void transpose_item(const float* W, int K, int N, bf16* WT, int kb, int n0, int row_base, LAS float* scr, int lane, const float* gvec) {
    const int k0 = 64 * kb;
#pragma unroll 8
    for (int i = 0; i < 32; ++i) { const int kk = 2 * i + (lane >> 5); scr[kk * 33 + (lane & 31)] = W[(size_t)(k0 + kk) * N + n0 + (lane & 31)]; }
    asm volatile("s_waitcnt lgkmcnt(0)" ::: "memory");
    const int c = lane & 7;
#pragma unroll
    for (int j = 0; j < 4; ++j) { const int n = (lane >> 3) + 8 * j; const LAS float* s = scr + (8 * c) * 33 + n;
        uint4 o; o.x = pk2(s[0 * 33], s[1 * 33]); o.y = pk2(s[2 * 33], s[3 * 33]); o.z = pk2(s[4 * 33], s[5 * 33]); o.w = pk2(s[6 * 33], s[7 * 33]);
        *(uint4*)(WT + (size_t)(row_base + n) * K + k0 + 8 * c) = o; }
    asm volatile("s_waitcnt lgkmcnt(0)" ::: "memory");
}
__device__ __forceinline__ void convert_weights(const Params& p, int L, LAS unsigned char* lds, int G) {
    int tid = threadIdx.x; asm volatile("" : "+v"(tid));
    const int lane = tid & 63, wave = __builtin_amdgcn_readfirstlane(tid >> 6);
    const int gw = blockIdx.x * NWAVES + wave, NGW = G * NWAVES;
    LAS float* scr = (LAS float*)(lds + wave * 16384);
    bf16* WB = (bf16*)(p.ws + WS_W);
    constexpr int I_UP = (D / 64) * (FF / 32), I_DN = (FF / 64) * (D / 32), I_IN = (D / 64) * (DIN / 32), I_BR = (512 / 64) * (D / 32), I_OUT = (D / 64) * (D / 32);
    constexpr int NITEMS = 4 * I_UP + 2 * I_DN + I_IN + 3 * I_BR + I_OUT;
#pragma unroll 1
    for (int it = gw; it < NITEMS; it += NGW) {
        int r = it; const float* W; int K, N, mode = 0, row_off = 0; size_t wo; const float* gv = nullptr;
        const float* gin1 = L ? p.in[20] + (size_t)(L - 1) * D : nullptr;
        if (r < I_UP) { W = p.in[2] + (size_t)L * D * FF; K = D; N = FF; mode = 1; wo = WO_W1C; }
        else if ((r -= I_UP) < I_UP) { W = p.in[3] + (size_t)L * D * FF; K = D; N = FF; mode = 2; wo = WO_W1C; }
        else if ((r -= I_UP) < I_DN) { W = p.in[4] + (size_t)L * FF * D; K = FF; N = D; wo = WO_W1D; }
        else if ((r -= I_DN) < I_IN) { W = p.in[7] + (size_t)L * D * DIN; K = D; N = DIN; wo = WO_WIN; }
        else if ((r -= I_IN) < I_BR) { W = p.in[11] + (size_t)L * 512 * D; K = 512; N = D; wo = WO_PBR; }
        else if ((r -= I_BR) < I_BR) { W = p.in[12] + (size_t)L * 512 * D; K = 512; N = D; wo = WO_PBR; row_off = 1024; }
        else if ((r -= I_BR) < I_BR) { W = p.in[13] + (size_t)L * 512 * D; K = 512; N = D; wo = WO_PBR; row_off = 2048; }
        else if ((r -= I_BR) < I_OUT) { W = p.in[14] + (size_t)L * D * D; K = D; N = D; wo = WO_WOUT; }
        else if ((r -= I_OUT) < I_UP) { W = p.in[17] + (size_t)L * D * FF; K = D; N = FF; mode = 1; wo = WO_W2C; }
        else if ((r -= I_UP) < I_UP) { W = p.in[18] + (size_t)L * D * FF; K = D; N = FF; mode = 2; wo = WO_W2C; }
        else { r -= I_UP; W = p.in[19] + (size_t)L * FF * D; K = FF; N = D; wo = WO_W2D; }
        const int nblk = N / 32, kb = r / nblk, n0 = (r % nblk) * 32;
        int row_base = row_off + n0;
        if (mode) row_base = (n0 >> 7) * 256 + (mode == 2 ? 128 : 0) + (n0 & 127);
        int ln = lane; asm volatile("" : "+v"(ln));
        transpose_item(W, K, N, WB + wo, kb, n0, row_base, scr, ln, gv);
    }
}

__device__ __forceinline__ void convert_rows(const float* src, bf16* xb, int nrows, int gtid, int gthreads) {
    const int n4 = nrows * (D / 4);
    for (int i = gtid; i < n4; i += 4 * gthreads) {
        f32x4 v[4];
#pragma unroll
        for (int k = 0; k < 4; ++k) { const int j = i + k * gthreads; if (j < n4) v[k] = __builtin_nontemporal_load((const f32x4*)src + j); }
#pragma unroll
        for (int k = 0; k < 4; ++k) { const int j = i + k * gthreads; if (j < n4) { uint2 o; o.x = pk2(v[k].x, v[k].y); o.y = pk2(v[k].z, v[k].w); ((uint2*)xb)[j] = o; } }
    }
}
template <bool FINAL>
__device__ __forceinline__ void ln_pass(float* V, bf16* xb, float* RS, const float* g, const float* b, int nrows, int gw, int NGW, int lane) {
    f32x4 gv[4], bv[4];
#pragma unroll
    for (int j = 0; j < 4; ++j) { gv[j] = ((const f32x4*)g)[lane + 64 * j]; bv[j] = ((const f32x4*)b)[lane + 64 * j]; }
    for (int m = gw; m < nrows; m += NGW) {
        f32x4* xr = (f32x4*)(V + (size_t)m * D) + lane;
        f32x4 v[4]; float s = 0.f;
#pragma unroll
        for (int j = 0; j < 4; ++j) { v[j] = xr[64 * j]; s += (v[j].x + v[j].y) + (v[j].z + v[j].w); }
        const float mean = wave_sum(s) * (1.f / D); float s2 = 0.f;
#pragma unroll
        for (int j = 0; j < 4; ++j) { v[j] = v[j] - mean; s2 += (v[j].x * v[j].x + v[j].y * v[j].y) + (v[j].z * v[j].z + v[j].w * v[j].w); }
        const float rstd = 1.f / sqrtf(wave_sum(s2) * (1.f / D) + LN_EPS);
        if (FINAL) {
#pragma unroll
            for (int j = 0; j < 4; ++j) xr[64 * j] = v[j] * rstd * gv[j] + bv[j];
        } else {
            if (lane == 0) { float2 st; st.x = mean; st.y = rstd; *(float2*)(RS + (size_t)m * 2) = st; }
            uint2* o8 = (uint2*)(xb + (size_t)m * D) + lane;
#pragma unroll
            for (int j = 0; j < 4; ++j) { const f32x4 y = v[j] * rstd * gv[j] + bv[j]; uint2 o; o.x = pk2(y.x, y.y); o.y = pk2(y.z, y.w); o8[64 * j] = o; }
        }
    }
}

__device__ __forceinline__ void mixA_unit(const bf16* Z, bf16* Ya, int tc0, int S, int h, int tid) {
    const int ql = tid >> 3, sub = tid & 7;
    const int tc = tc0 + ql, seq0 = (tc / S) * S, t = tc - seq0;
    const bf16* zq = Z + (size_t)tc * NZ;
    const float slope = exp2f(-(float)(h + 1));
    float m = -1e30f, l = 0.f, o[8];
#pragma unroll
    for (int i = 0; i < 8; ++i) o[i] = 0.f;
#pragma unroll 1
    for (int g = 0; g < 3; ++g) {
        const int dil = 1 << (2 * g);
        float q[8]; unpack8(*(const uint4*)(zq + g * 512 + h * 64 + sub * 8), q);
#pragma unroll
        for (int i = 0; i < 8; ++i) q[i] *= 0.125f;
        const bf16* kbase = Z + (size_t)seq0 * NZ + 1536 + g * 512 + h * 64 + sub * 8;
#pragma unroll 1
        for (int jj = 0; jj <= 128; ++jj) {
            const int j = jj - 64, s = t + j * dil; const bool valid = (s >= 0) && (s < S); const int sc_ = valid ? s : t;
            const bf16* kp = kbase + (size_t)sc_ * NZ;
            float k[8], v[8]; unpack8(*(const uint4*)kp, k); unpack8(*(const uint4*)(kp + 1536), v);
            float dot = 0.f;
#pragma unroll
            for (int i = 0; i < 8; ++i) dot += q[i] * k[i];
            dot += __shfl_xor(dot, 1); dot += __shfl_xor(dot, 2); dot += __shfl_xor(dot, 4);
            const float sc = dot - slope * (float)((j < 0 ? -j : j) * dil);
            const float mn = valid ? fmaxf(m, sc) : m;
            const float corr = __expf(m - mn), pe = valid ? __expf(sc - mn) : 0.f;
            l = l * corr + pe;
#pragma unroll
            for (int i = 0; i < 8; ++i) o[i] = o[i] * corr + pe * v[i];
            m = mn;
        }
    }
    const float inv = 1.f / l;
    uint4 w; w.x = pk2(o[0] * inv, o[1] * inv); w.y = pk2(o[2] * inv, o[3] * inv); w.z = pk2(o[4] * inv, o[5] * inv); w.w = pk2(o[6] * inv, o[7] * inv);
    *(uint4*)(Ya + (size_t)tc * 512 + h * 64 + sub * 8) = w;
}
__device__ __forceinline__ void mixC_unit(const bf16* Z, bf16* Yc, const float* rpb, int tc0, int S, int h, int tid) {
    const int ql = tid >> 3, sub = tid & 7;
    const int tc = tc0 + ql, seq0 = (tc / S) * S, t = tc - seq0;
    const int rows = S / 64, qr = t >> 6, qc = t & 63;
    int rs = qr - 4; rs = rs < 0 ? 0 : (rs > rows - 8 ? rows - 8 : rs);
    int cs = qc - 8; cs = cs < 0 ? 0 : (cs > 48 ? 48 : cs);
    float q[8]; unpack8(*(const uint4*)(Z + (size_t)tc * NZ + 6144 + h * 64 + sub * 8), q);
#pragma unroll
    for (int i = 0; i < 8; ++i) q[i] *= 0.125f;
    const bf16* kbase = Z + (size_t)seq0 * NZ + 6656 + h * 64 + sub * 8;
    const float* rb = rpb + h * 15 * 31;
    float m = -1e30f, l = 0.f, o[8];
#pragma unroll
    for (int i = 0; i < 8; ++i) o[i] = 0.f;
#pragma unroll 2
    for (int kk = 0; kk < 128; ++kk) {
        const int kr = rs + (kk >> 4), kc = cs + (kk & 15), s = kr * 64 + kc;
        const bf16* kp = kbase + (size_t)s * NZ;
        float k[8], v[8]; unpack8(*(const uint4*)kp, k); unpack8(*(const uint4*)(kp + 512), v);
        float dot = 0.f;
#pragma unroll
        for (int i = 0; i < 8; ++i) dot += q[i] * k[i];
        dot += __shfl_xor(dot, 1); dot += __shfl_xor(dot, 2); dot += __shfl_xor(dot, 4);
        const float sc = dot + rb[(kr - qr + 7) * 31 + (kc - qc + 15)];
        const float mn = fmaxf(m, sc);
        const float corr = __expf(m - mn), pe = __expf(sc - mn);
        l = l * corr + pe;
#pragma unroll
        for (int i = 0; i < 8; ++i) o[i] = o[i] * corr + pe * v[i];
        m = mn;
    }
    const float inv = 1.f / l;
    uint4 w; w.x = pk2(o[0] * inv, o[1] * inv); w.y = pk2(o[2] * inv, o[3] * inv); w.z = pk2(o[4] * inv, o[5] * inv); w.w = pk2(o[6] * inv, o[7] * inv);
    *(uint4*)(Yc + (size_t)tc * 512 + h * 64 + sub * 8) = w;
}
__device__ __forceinline__ void mixB1_unit(const bf16* Z, float* ST, int gn, int hb, float lgf, float lgb, int tid) {
    const int d = tid >> 3, eb = (tid & 7) * 16;
    float f[16], b[16];
#pragma unroll
    for (int i = 0; i < 16; ++i) { f[i] = 0.f; b[i] = 0.f; }
    const bf16* zb = Z + (size_t)gn * 128 * NZ;
#pragma unroll 2
    for (int j = 0; j < 128; ++j) {
        const bf16* zr = zb + (size_t)j * NZ;
        const float kd = bf2f(zr[4864 + hb * 64 + d]) * 0.125f;
        float v[16]; unpack8(*(const uint4*)(zr + 5120 + hb * 128 + eb), v); unpack8(*(const uint4*)(zr + 5120 + hb * 128 + eb + 8), v + 8);
        const float wf = kd * __expf(lgf * (float)(127 - j)), wb = kd * __expf(lgb * (float)j);
#pragma unroll
        for (int i = 0; i < 16; ++i) { f[i] += wf * v[i]; b[i] += wb * v[i]; }
    }
    float* pf = ST + ((size_t)(0 * 4 + hb) * 128 + gn) * 8192 + d * 128 + eb;
    float* pb = ST + ((size_t)(1 * 4 + hb) * 128 + gn) * 8192 + d * 128 + eb;
#pragma unroll
    for (int i = 0; i < 4; ++i) { ((f32x4*)pf)[i] = (f32x4){f[4 * i], f[4 * i + 1], f[4 * i + 2], f[4 * i + 3]}; ((f32x4*)pb)[i] = (f32x4){b[4 * i], b[4 * i + 1], b[4 * i + 2], b[4 * i + 3]}; }
}
__device__ __forceinline__ float log_sigmoid2_(float x) { return -log1pf(__expf(-x)); }
__device__ __forceinline__ void mixB2(float* ST, int S, int nseq, const float* lgf4, const float* lgb4, int gtid, int gthreads) {
    const int N = S / 128, total = 2 * 4 * nseq * 8192;
    for (int id = gtid; id < total; id += gthreads) {
        const int el = id & 8191; int r = id >> 13; const int sq = r % nseq; r /= nseq; const int hb = r & 3, dir = r >> 2;
        const float lg = log_sigmoid2_(dir ? lgb4[hb] : lgf4[hb]); const float decay = __expf(lg * 128.f);
        float* p = ST + ((size_t)(dir * 4 + hb) * 128 + sq * N) * 8192 + el;
        float s = 0.f;
        for (int n0 = 0; n0 < N; n0 += 8) {
            float tmp[8];
#pragma unroll
            for (int i = 0; i < 8; ++i) { const int n = dir ? (N - 1 - (n0 + i)) : (n0 + i); tmp[i] = p[(size_t)n * 8192]; }
#pragma unroll
            for (int i = 0; i < 8; ++i) { const int n = dir ? (N - 1 - (n0 + i)) : (n0 + i); p[(size_t)n * 8192] = s; s = decay * s + tmp[i]; }
        }
    }
}
__device__ __forceinline__ void mixB3_unit(const bf16* Z, const float* ST, bf16* Yb, int gn, int hb, float lgf, float lgb, int tid) {
    const int i = tid >> 2, sub = tid & 3;
    const int tc = gn * 128 + i;
    const bf16* zq = Z + (size_t)tc * NZ;
    float q[64];
#pragma unroll
    for (int c = 0; c < 8; ++c) unpack8(*(const uint4*)(zq + 4608 + hb * 64 + c * 8), q + c * 8);
    float o[32];
#pragma unroll
    for (int e = 0; e < 32; ++e) o[e] = 0.f;
    const bf16* zb = Z + (size_t)gn * 128 * NZ;
#pragma unroll 1
    for (int j = 0; j < 128; ++j) {
        const bf16* zr = zb + (size_t)j * NZ;
        float dot = 0.f;
#pragma unroll
        for (int c = 0; c < 8; ++c) { float k[8]; unpack8(*(const uint4*)(zr + 4864 + hb * 64 + c * 8), k);
#pragma unroll
            for (int x = 0; x < 8; ++x) dot += q[c * 8 + x] * k[x]; }
        const float w = dot * 0.125f * (j <= i ? __expf(lgf * (float)(i - j)) : __expf(lgb * (float)(j - i)));
#pragma unroll
        for (int c = 0; c < 4; ++c) { float v[8]; unpack8(*(const uint4*)(zr + 5120 + hb * 128 + sub * 32 + c * 8), v);
#pragma unroll
            for (int x = 0; x < 8; ++x) o[c * 8 + x] += w * v[x]; }
    }
    const float cf = __expf(lgf * (float)(i + 1)), cb = __expf(lgb * (float)(128 - i));
    const float* Sf = ST + ((size_t)(0 * 4 + hb) * 128 + gn) * 8192 + sub * 32;
    const float* Sb = ST + ((size_t)(1 * 4 + hb) * 128 + gn) * 8192 + sub * 32;
#pragma unroll 2
    for (int d = 0; d < 64; ++d) {
        const float qd = bf2f(zq[4608 + hb * 64 + d]); const float a = qd * cf, b = qd * cb;
#pragma unroll
        for (int c = 0; c < 8; ++c) { const f32x4 sf = ((const f32x4*)(Sf + d * 128))[c], sb = ((const f32x4*)(Sb + d * 128))[c];
            o[4 * c] += a * sf.x + b * sb.x; o[4 * c + 1] += a * sf.y + b * sb.y; o[4 * c + 2] += a * sf.z + b * sb.z; o[4 * c + 3] += a * sf.w + b * sb.w; }
    }
    float s1 = 0.f;
#pragma unroll
    for (int e = 0; e < 32; ++e) s1 += o[e];
    s1 += __shfl_xor(s1, 1); s1 += __shfl_xor(s1, 2);
    const float mu = s1 * (1.f / 128.f);
    float s2 = 0.f;
#pragma unroll
    for (int e = 0; e < 32; ++e) { o[e] -= mu; s2 += o[e] * o[e]; }
    s2 += __shfl_xor(s2, 1); s2 += __shfl_xor(s2, 2);
    const float rstd = 1.f / sqrtf(s2 * (1.f / 128.f) + GN_EPS);
#pragma unroll
    for (int c = 0; c < 4; ++c) {
        float gt[8]; unpack8(*(const uint4*)(zq + 5632 + hb * 128 + sub * 32 + c * 8), gt);
        float y[8];
#pragma unroll
        for (int x = 0; x < 8; ++x) y[x] = o[c * 8 + x] * rstd * gt[x] * pg8::sigmoidf_(gt[x]);
        uint4 w; w.x = pk2(y[0], y[1]); w.y = pk2(y[2], y[3]); w.z = pk2(y[4], y[5]); w.w = pk2(y[6], y[7]);
        *(uint4*)(Yb + (size_t)tc * 512 + hb * 128 + sub * 32 + c * 8) = w;
    }
}

typedef short bf16x8_t __attribute__((ext_vector_type(8)));
typedef short s16x4_t __attribute__((ext_vector_type(4)));
__device__ __forceinline__ s16x4_t trread(LAS unsigned char* p) { return __builtin_amdgcn_ds_read_tr16_b64_v4i16((LAS s16x4_t*)p); }
__device__ __forceinline__ bf16x8_t cat4(s16x4_t a, s16x4_t b) { return (bf16x8_t){a[0], a[1], a[2], a[3], b[0], b[1], b[2], b[3]}; }
__device__ __forceinline__ bf16x8_t packp(f32x4 a, f32x4 b) {
    uint4 w; w.x = pg8::cvt_pk_bf16(a[0], a[1]); w.y = pg8::cvt_pk_bf16(a[2], a[3]); w.z = pg8::cvt_pk_bf16(b[0], b[1]); w.w = pg8::cvt_pk_bf16(b[2], b[3]);
    return __builtin_bit_cast(bf16x8_t, w);
}
constexpr int KPITCH = 144;
constexpr int A_ROWS = 400, A_VOFF = A_ROWS * KPITCH;
constexpr int A_TOT = 2 * A_ROWS * 8, A_NIT = (A_TOT + NTHR - 1) / NTHR;
__device__ __forceinline__ void mixA_load(const bf16* Z, int u, int S, int tid, pg8::u32x4 (&buf)[A_NIT]) {
    const int g = u >> 9, h = u & 7, tt = (u >> 3) & 63;
    const int dil = 1 << (2 * g), Lg = S / dil, tps = S >> 8, tpr = Lg >> 8;
    const int sq = tt / tps, x = tt - sq * tps, r = x / tpr, i0 = (x - r * tpr) << 8;
    const bf16* zk = Z + (size_t)(sq * S) * NZ + 1536 + g * 512 + h * 64;
#pragma unroll
    for (int i = 0; i < A_NIT; ++i) {
        const int c = tid + i * NTHR; const int mat = c >= A_ROWS * 8, cc = c - mat * A_ROWS * 8, row = cc >> 3, ch = cc & 7, idx = i0 - 64 + row;
        buf[i] = (pg8::u32x4){0u, 0u, 0u, 0u};
        if (c < A_TOT && idx >= 0 && idx < Lg) buf[i] = *(const pg8::u32x4*)(zk + (size_t)(idx * dil + r) * NZ + mat * 1536 + ch * 8);
    }
}
__device__ __forceinline__ void mixA_store(LAS unsigned char* lds, int tid, const pg8::u32x4 (&buf)[A_NIT]) {
#pragma unroll
    for (int i = 0; i < A_NIT; ++i) {
        const int c = tid + i * NTHR; const int mat = c >= A_ROWS * 8, cc = c - mat * A_ROWS * 8, row = cc >> 3, ch = cc & 7;
        if (c < A_TOT) *(LAS pg8::u32x4*)(lds + mat * A_VOFF + row * KPITCH + ch * 16) = buf[i];
    }
}
__device__ __forceinline__ void mixA_compute(bf16* Z, float* LSE, LAS unsigned char* lds, int u, int S, int tid) {
    const int g = u >> 9, h = u & 7, tt = (u >> 3) & 63;
    const int dil = 1 << (2 * g), Lg = S / dil, tps = S >> 8, tpr = Lg >> 8;
    const int sq = tt / tps, x = tt - sq * tps, r = x / tpr, i0 = (x - r * tpr) << 8;
    const int seq0 = sq * S;
    const int lane = tid & 63, w = tid >> 6, n = lane & 15, q = lane >> 4;
#pragma unroll
    for (int qt = 0; qt < 2; ++qt) {
    const int wt = 2 * w + qt;
    const int iq = i0 + 16 * wt + n, tokc = seq0 + iq * dil + r;
    bf16* qp = Z + (size_t)tokc * NZ + g * 512 + h * 64;
    const bf16x8_t qf0 = *(const bf16x8_t*)(qp + 8 * q), qf1 = *(const bf16x8_t*)(qp + 32 + 8 * q);
    f32x4 s[10];
#pragma unroll
    for (int t = 0; t < 9; ++t) {
        LAS unsigned char* kp = lds + (16 * wt + 16 * t + n) * KPITCH + q * 16;
        const bf16x8_t kf0 = *(LAS bf16x8_t*)kp, kf1 = *(LAS bf16x8_t*)(kp + 64);
        f32x4 a = {0.f, 0.f, 0.f, 0.f};
        a = __builtin_amdgcn_mfma_f32_16x16x32_bf16(kf0, qf0, a, 0, 0, 0);
        s[t] = __builtin_amdgcn_mfma_f32_16x16x32_bf16(kf1, qf1, a, 0, 0, 0);
    }
    s[9] = (f32x4){0.f, 0.f, 0.f, 0.f};
    const float slope = exp2f(-(float)(h + 1)) * (float)dil;
    float m = -1e30f;
#pragma unroll
    for (int t = 0; t < 9; ++t)
#pragma unroll
        for (int j = 0; j < 4; ++j) {
            const int rel = 16 * t + 4 * q + j - 64 - n, idxk = i0 - 64 + 16 * wt + 16 * t + 4 * q + j;
            const bool valid = (rel >= -64) && (rel <= 64) && (idxk >= 0) && (idxk < Lg);
            const float sc = s[t][j] * 0.125f - slope * (float)(rel < 0 ? -rel : rel);
            s[t][j] = valid ? sc : -1e30f; m = fmaxf(m, s[t][j]);
        }
    m = fmaxf(m, __shfl_xor(m, 16)); m = fmaxf(m, __shfl_xor(m, 32));
    float l = 0.f;
#pragma unroll
    for (int t = 0; t < 9; ++t)
#pragma unroll
        for (int j = 0; j < 4; ++j) { const float pe = __expf(s[t][j] - m); s[t][j] = pe; l += pe; }
    l += __shfl_xor(l, 16); l += __shfl_xor(l, 32);
    f32x4 o[4];
#pragma unroll
    for (int dt = 0; dt < 4; ++dt) o[dt] = (f32x4){0.f, 0.f, 0.f, 0.f};
    LAS unsigned char* vb = lds + A_VOFF + (16 * wt + 4 * q + ((lane >> 2) & 3)) * KPITCH + 8 * (lane & 3);
#pragma unroll
    for (int G = 0; G < 5; ++G) {
        const bf16x8_t pb = packp(s[2 * G], s[2 * G + 1]);
#pragma unroll
        for (int dt = 0; dt < 4; ++dt) {
            const s16x4_t lo = trread(vb + (32 * G) * KPITCH + dt * 32), hi = trread(vb + (32 * G + 16) * KPITCH + dt * 32);
            o[dt] = __builtin_amdgcn_mfma_f32_16x16x32_bf16(cat4(lo, hi), pb, o[dt], 0, 0, 0);
        }
    }
    const float inv = 1.f / l;
#pragma unroll
    for (int dt = 0; dt < 4; ++dt) { uint2 wv; wv.x = pg8::cvt_pk_bf16(o[dt][0] * inv, o[dt][1] * inv); wv.y = pg8::cvt_pk_bf16(o[dt][2] * inv, o[dt][3] * inv);
        *(uint2*)(qp + dt * 16 + 4 * q) = wv; }
    if (q == 0) LSE[((size_t)g * MC + tokc) * 8 + h] = m + __logf(l);
    }
}
__device__ __forceinline__ void mixA_merge(const bf16* Z, const float* LSE, bf16* Ya, int gtid, int gthreads) {
    for (int it = gtid; it < MC * 64; it += gthreads) {
        const int tok = it >> 6, h = (it >> 3) & 7, ch = it & 7;
        const float l0 = LSE[((size_t)0 * MC + tok) * 8 + h], l1 = LSE[((size_t)1 * MC + tok) * 8 + h], l2 = LSE[((size_t)2 * MC + tok) * 8 + h];
        const float mx = fmaxf(l0, fmaxf(l1, l2));
        float w0 = __expf(l0 - mx), w1 = __expf(l1 - mx), w2 = __expf(l2 - mx); const float inv = 1.f / (w0 + w1 + w2); w0 *= inv; w1 *= inv; w2 *= inv;
        const bf16* zp = Z + (size_t)tok * NZ + h * 64 + ch * 8;
        float a[8], b[8], c[8]; unpack8(*(const uint4*)zp, a); unpack8(*(const uint4*)(zp + 512), b); unpack8(*(const uint4*)(zp + 1024), c);
        uint4 wv; wv.x = pk2(w0 * a[0] + w1 * b[0] + w2 * c[0], w0 * a[1] + w1 * b[1] + w2 * c[1]); wv.y = pk2(w0 * a[2] + w1 * b[2] + w2 * c[2], w0 * a[3] + w1 * b[3] + w2 * c[3]);
        wv.z = pk2(w0 * a[4] + w1 * b[4] + w2 * c[4], w0 * a[5] + w1 * b[5] + w2 * c[5]); wv.w = pk2(w0 * a[6] + w1 * b[6] + w2 * c[6], w0 * a[7] + w1 * b[7] + w2 * c[7]);
        *(uint4*)(Ya + (size_t)tok * 512 + h * 64 + ch * 8) = wv;
    }
}
constexpr int C_ROWS = 704;
__device__ __forceinline__ void mixC_mfma_unit(const bf16* Z, bf16* Yc, const float* rpb, LAS unsigned char* lds, int u, int S, int tid) {
    const int h = u & 7, rp = u >> 3, rps = S >> 8, sq = rp / rps, np = rp - sq * rps, seq0 = sq * S, rows = S >> 6;
    const int lane = tid & 63, w = tid >> 6, n = lane & 15, q = lane >> 4;
    int rb = 4 * np - 4; rb = rb < 0 ? 0 : (rb > rows - 11 ? rows - 11 : rb);
    const bf16* zk = Z + (size_t)seq0 * NZ + 6656 + h * 64;
    __syncthreads();
    {
        constexpr int NIT = C_ROWS * 8 / NTHR;
        pg8::u32x4 buf[NIT];
#pragma unroll
        for (int i = 0; i < NIT; ++i) { const int c = tid + i * NTHR, row = c >> 3, ch = c & 7; buf[i] = *(const pg8::u32x4*)(zk + (size_t)(rb * 64 + row) * NZ + 512 + ch * 8); }
#pragma unroll
        for (int i = 0; i < NIT; ++i) { const int c = tid + i * NTHR, row = c >> 3, ch = c & 7; *(LAS pg8::u32x4*)(lds + row * KPITCH + ch * 16) = buf[i]; }
        if (tid < 15 * 31) ((LAS float*)(lds + C_ROWS * KPITCH))[tid] = rpb[h * 15 * 31 + tid];
    }
    __syncthreads();
#pragma unroll
    for (int qt = 0; qt < 2; ++qt) {
    const int qr = 4 * np + 2 * qt + (w >> 2), cb = w & 3, qc = cb * 16 + n;
    int rs = qr - 4; rs = rs < 0 ? 0 : (rs > rows - 8 ? rows - 8 : rs);
    int cbs = cb * 16 - 8; cbs = cbs < 0 ? 0 : (cbs > 32 ? 32 : cbs);
    int cs = qc - 8; cs = cs < 0 ? 0 : (cs > 48 ? 48 : cs);
    const int tokc = seq0 + qr * 64 + qc;
    const bf16* qp = Z + (size_t)tokc * NZ + 6144 + h * 64;
    const bf16x8_t qf0 = *(const bf16x8_t*)(qp + 8 * q), qf1 = *(const bf16x8_t*)(qp + 32 + 8 * q);
    f32x4 s[16];
#pragma unroll
    for (int hf = 0; hf < 2; ++hf) {
        bf16x8_t kf[8][2];
#pragma unroll
        for (int tt = 0; tt < 8; ++tt) { const int t = 8 * hf + tt;
            const bf16* kp = zk + (size_t)((rs + (t >> 1)) * 64 + cbs + (t & 1) * 16 + n) * NZ + 8 * q;
            kf[tt][0] = *(const bf16x8_t*)kp; kf[tt][1] = *(const bf16x8_t*)(kp + 32); }
#pragma unroll
        for (int tt = 0; tt < 8; ++tt) {
            f32x4 a = {0.f, 0.f, 0.f, 0.f};
            a = __builtin_amdgcn_mfma_f32_16x16x32_bf16(kf[tt][0], qf0, a, 0, 0, 0);
            s[8 * hf + tt] = __builtin_amdgcn_mfma_f32_16x16x32_bf16(kf[tt][1], qf1, a, 0, 0, 0);
        }
        __builtin_amdgcn_sched_barrier(0);
    }
    const LAS float* rbp = (const LAS float*)(lds + C_ROWS * KPITCH);
    float m = -1e30f;
#pragma unroll
    for (int t = 0; t < 16; ++t)
#pragma unroll
        for (int j = 0; j < 4; ++j) {
            const int kr = rs + (t >> 1), kc = cbs + (t & 1) * 16 + 4 * q + j;
            const bool valid = (kc >= cs) && (kc < cs + 16);
            int dc = kc - qc + 15; dc = dc < 0 ? 0 : (dc > 30 ? 30 : dc);
            const float sc = s[t][j] * 0.125f + rbp[(kr - qr + 7) * 31 + dc];
            s[t][j] = valid ? sc : -1e30f; m = fmaxf(m, s[t][j]);
        }
    m = fmaxf(m, __shfl_xor(m, 16)); m = fmaxf(m, __shfl_xor(m, 32));
    float l = 0.f;
#pragma unroll
    for (int t = 0; t < 16; ++t)
#pragma unroll
        for (int j = 0; j < 4; ++j) { const float pe = __expf(s[t][j] - m); s[t][j] = pe; l += pe; }
    l += __shfl_xor(l, 16); l += __shfl_xor(l, 32);
    f32x4 o[4];
#pragma unroll
    for (int dt = 0; dt < 4; ++dt) o[dt] = (f32x4){0.f, 0.f, 0.f, 0.f};
    LAS unsigned char* vb = lds + ((rs - rb) * 64 + cbs + 4 * q + ((lane >> 2) & 3)) * KPITCH + 8 * (lane & 3);
#pragma unroll
    for (int G = 0; G < 8; ++G) {
        const bf16x8_t pb = packp(s[2 * G], s[2 * G + 1]);
#pragma unroll
        for (int dt = 0; dt < 4; ++dt) {
            const s16x4_t lo = trread(vb + (64 * G) * KPITCH + dt * 32), hi = trread(vb + (64 * G + 16) * KPITCH + dt * 32);
            o[dt] = __builtin_amdgcn_mfma_f32_16x16x32_bf16(cat4(lo, hi), pb, o[dt], 0, 0, 0);
        }
    }
    const float inv = 1.f / l;
    bf16* yp = Yc + (size_t)tokc * 512 + h * 64;
#pragma unroll
    for (int dt = 0; dt < 4; ++dt) { uint2 wv; wv.x = pg8::cvt_pk_bf16(o[dt][0] * inv, o[dt][1] * inv); wv.y = pg8::cvt_pk_bf16(o[dt][2] * inv, o[dt][3] * inv);
        *(uint2*)(yp + dt * 16 + 4 * q) = wv; }
    }
}

constexpr int VPITCH = 288;
constexpr int B1_V = 0, B1_KF = 128 * VPITCH, B1_KB = B1_KF + 128 * KPITCH;
__device__ __forceinline__ void mixB1_mfma_unit(const bf16* Z, float* ST, LAS unsigned char* lds, int gn, int hb, float lgf, float lgb, int tid) {
    const int lane = tid & 63, w = tid >> 6, n = lane & 15, q = lane >> 4;
    const bf16* zb = Z + (size_t)gn * 128 * NZ;
    __syncthreads();
    {
        pg8::u32x4 vbuf[4]; uint4 kbuf[2];
#pragma unroll
        for (int i = 0; i < 4; ++i) { const int c = tid + i * NTHR, row = c >> 4, ch = c & 15; vbuf[i] = *(const pg8::u32x4*)(zb + (size_t)row * NZ + 5120 + hb * 128 + ch * 8); }
#pragma unroll
        for (int i = 0; i < 2; ++i) { const int c = tid + i * NTHR, row = c >> 3, ch = c & 7; kbuf[i] = *(const uint4*)(zb + (size_t)row * NZ + 4864 + hb * 64 + ch * 8); }
#pragma unroll
        for (int i = 0; i < 4; ++i) { const int c = tid + i * NTHR, row = c >> 4, ch = c & 15; *(LAS pg8::u32x4*)(lds + B1_V + row * VPITCH + ch * 16) = vbuf[i]; }
#pragma unroll
        for (int i = 0; i < 2; ++i) { const int c = tid + i * NTHR, row = c >> 3, ch = c & 7;
            float k[8]; unpack8(kbuf[i], k);
            const float wf = 0.125f * __expf(lgf * (float)(127 - row)), wb = 0.125f * __expf(lgb * (float)row);
            pg8::u32x4 a, b;
            a.x = pg8::cvt_pk_bf16(k[0] * wf, k[1] * wf); a.y = pg8::cvt_pk_bf16(k[2] * wf, k[3] * wf); a.z = pg8::cvt_pk_bf16(k[4] * wf, k[5] * wf); a.w = pg8::cvt_pk_bf16(k[6] * wf, k[7] * wf);
            b.x = pg8::cvt_pk_bf16(k[0] * wb, k[1] * wb); b.y = pg8::cvt_pk_bf16(k[2] * wb, k[3] * wb); b.z = pg8::cvt_pk_bf16(k[4] * wb, k[5] * wb); b.w = pg8::cvt_pk_bf16(k[6] * wb, k[7] * wb);
            *(LAS pg8::u32x4*)(lds + B1_KF + row * KPITCH + ch * 16) = a; *(LAS pg8::u32x4*)(lds + B1_KB + row * KPITCH + ch * 16) = b; }
    }
    __syncthreads();
    f32x4 af[4], ab[4];
#pragma unroll
    for (int dt = 0; dt < 4; ++dt) { af[dt] = (f32x4){0.f, 0.f, 0.f, 0.f}; ab[dt] = (f32x4){0.f, 0.f, 0.f, 0.f}; }
    const int rsel = 4 * q + ((lane >> 2) & 3), csel = 8 * (lane & 3);
#pragma unroll
    for (int js = 0; js < 4; ++js) {
        LAS unsigned char* vp = lds + B1_V + (32 * js + rsel) * VPITCH + w * 32 + csel;
        const bf16x8_t va = cat4(trread(vp), trread(vp + 16 * VPITCH));
#pragma unroll
        for (int dt = 0; dt < 4; ++dt) {
            LAS unsigned char* kf = lds + B1_KF + (32 * js + rsel) * KPITCH + dt * 32 + csel;
            LAS unsigned char* kb = lds + B1_KB + (32 * js + rsel) * KPITCH + dt * 32 + csel;
            af[dt] = __builtin_amdgcn_mfma_f32_16x16x32_bf16(va, cat4(trread(kf), trread(kf + 16 * KPITCH)), af[dt], 0, 0, 0);
            ab[dt] = __builtin_amdgcn_mfma_f32_16x16x32_bf16(va, cat4(trread(kb), trread(kb + 16 * KPITCH)), ab[dt], 0, 0, 0);
        }
    }
    float* pf = ST + ((size_t)(0 * 4 + hb) * 128 + gn) * 8192 + 16 * w + 4 * q;
    float* pb = ST + ((size_t)(1 * 4 + hb) * 128 + gn) * 8192 + 16 * w + 4 * q;
#pragma unroll
    for (int dt = 0; dt < 4; ++dt) { *(f32x4*)(pf + (dt * 16 + n) * 128) = af[dt]; *(f32x4*)(pb + (dt * 16 + n) * 128) = ab[dt]; }
}
constexpr int B3_K = 0, B3_V = 128 * KPITCH, B3_SF = B3_V + 128 * VPITCH, B3_SB = B3_SF + 64 * VPITCH;
__device__ __forceinline__ void mixB3_mfma_unit(const bf16* Z, const float* ST, bf16* Yb, LAS unsigned char* lds, int gn, int hb, float lgf, float lgb, int tid) {
    const int lane = tid & 63, w = tid >> 6, n = lane & 15, q = lane >> 4;
    const bf16* zb = Z + (size_t)gn * 128 * NZ;
    const float* Sf = ST + ((size_t)(0 * 4 + hb) * 128 + gn) * 8192;
    const float* Sb = ST + ((size_t)(1 * 4 + hb) * 128 + gn) * 8192;
    __syncthreads();
    {
        pg8::u32x4 kbuf[2], vbuf[4]; f32x4 sbuf[4][2];
#pragma unroll
        for (int i = 0; i < 2; ++i) { const int c = tid + i * NTHR, row = c >> 3, ch = c & 7; kbuf[i] = *(const pg8::u32x4*)(zb + (size_t)row * NZ + 4864 + hb * 64 + ch * 8); }
#pragma unroll
        for (int i = 0; i < 4; ++i) { const int c = tid + i * NTHR, row = c >> 4, ch = c & 15; vbuf[i] = *(const pg8::u32x4*)(zb + (size_t)row * NZ + 5120 + hb * 128 + ch * 8); }
#pragma unroll
        for (int i = 0; i < 4; ++i) { const int c = tid + i * NTHR, dir = c >> 10, cc = c & 1023, row = cc >> 4, ch = cc & 15;
            const float* sp = (dir ? Sb : Sf) + row * 128 + ch * 8; sbuf[i][0] = *(const f32x4*)sp; sbuf[i][1] = *(const f32x4*)(sp + 4); }
#pragma unroll
        for (int i = 0; i < 2; ++i) { const int c = tid + i * NTHR, row = c >> 3, ch = c & 7; *(LAS pg8::u32x4*)(lds + B3_K + row * KPITCH + ch * 16) = kbuf[i]; }
#pragma unroll
        for (int i = 0; i < 4; ++i) { const int c = tid + i * NTHR, row = c >> 4, ch = c & 15; *(LAS pg8::u32x4*)(lds + B3_V + row * VPITCH + ch * 16) = vbuf[i]; }
#pragma unroll
        for (int i = 0; i < 4; ++i) { const int c = tid + i * NTHR, dir = c >> 10, cc = c & 1023, row = cc >> 4, ch = cc & 15;
            const f32x4 x0 = sbuf[i][0], x1 = sbuf[i][1];
            pg8::u32x4 a; a.x = pg8::cvt_pk_bf16(x0[0], x0[1]); a.y = pg8::cvt_pk_bf16(x0[2], x0[3]); a.z = pg8::cvt_pk_bf16(x1[0], x1[1]); a.w = pg8::cvt_pk_bf16(x1[2], x1[3]);
            *(LAS pg8::u32x4*)(lds + (dir ? B3_SB : B3_SF) + row * VPITCH + ch * 16) = a; }
    }
    __syncthreads();
    const int i = 16 * w + n, tokc = gn * 128 + i;
    const bf16* qp = Z + (size_t)tokc * NZ + 4608 + hb * 64;
    const int rsel = 4 * q + ((lane >> 2) & 3), csel = 8 * (lane & 3);
    f32x4 o[8];
    {
        const uint2 a0 = *(const uint2*)(qp + 4 * q), a1 = *(const uint2*)(qp + 16 + 4 * q), a2 = *(const uint2*)(qp + 32 + 4 * q), a3 = *(const uint2*)(qp + 48 + 4 * q);
        const bf16x8_t qc0 = __builtin_bit_cast(bf16x8_t, (uint4){a0.x, a0.y, a1.x, a1.y}), qc1 = __builtin_bit_cast(bf16x8_t, (uint4){a2.x, a2.y, a3.x, a3.y});
        const float cf = __expf(lgf * (float)(i + 1)), cb = __expf(lgb * (float)(128 - i));
#pragma unroll
        for (int et = 0; et < 8; ++et) {
            LAS unsigned char* sf = lds + B3_SF + rsel * VPITCH + et * 32 + csel;
            LAS unsigned char* sb = lds + B3_SB + rsel * VPITCH + et * 32 + csel;
            f32x4 f = {0.f, 0.f, 0.f, 0.f}, b = {0.f, 0.f, 0.f, 0.f};
            f = __builtin_amdgcn_mfma_f32_16x16x32_bf16(cat4(trread(sf), trread(sf + 16 * VPITCH)), qc0, f, 0, 0, 0);
            f = __builtin_amdgcn_mfma_f32_16x16x32_bf16(cat4(trread(sf + 32 * VPITCH), trread(sf + 48 * VPITCH)), qc1, f, 0, 0, 0);
            b = __builtin_amdgcn_mfma_f32_16x16x32_bf16(cat4(trread(sb), trread(sb + 16 * VPITCH)), qc0, b, 0, 0, 0);
            b = __builtin_amdgcn_mfma_f32_16x16x32_bf16(cat4(trread(sb + 32 * VPITCH), trread(sb + 48 * VPITCH)), qc1, b, 0, 0, 0);
            o[et] = f * cf + b * cb;
        }
    }
    {
        const bf16x8_t qf0 = *(const bf16x8_t*)(qp + 8 * q), qf1 = *(const bf16x8_t*)(qp + 32 + 8 * q);
        f32x4 s[8];
#pragma unroll
        for (int t = 0; t < 8; ++t) {
            LAS unsigned char* kp = lds + B3_K + (16 * t + n) * KPITCH + q * 16;
            f32x4 a = {0.f, 0.f, 0.f, 0.f};
            a = __builtin_amdgcn_mfma_f32_16x16x32_bf16(*(LAS bf16x8_t*)kp, qf0, a, 0, 0, 0);
            a = __builtin_amdgcn_mfma_f32_16x16x32_bf16(*(LAS bf16x8_t*)(kp + 64), qf1, a, 0, 0, 0);
#pragma unroll
            for (int j = 0; j < 4; ++j) { const int jj = 16 * t + 4 * q + j; const float dcy = (jj <= i) ? __expf(lgf * (float)(i - jj)) : __expf(lgb * (float)(jj - i)); a[j] = a[j] * 0.125f * dcy; }
            s[t] = a;
        }
#pragma unroll
        for (int G = 0; G < 4; ++G) {
            const bf16x8_t pb = packp(s[2 * G], s[2 * G + 1]);
#pragma unroll
            for (int et = 0; et < 8; ++et) {
                LAS unsigned char* vp = lds + B3_V + (32 * G + rsel) * VPITCH + et * 32 + csel;
                o[et] = __builtin_amdgcn_mfma_f32_16x16x32_bf16(cat4(trread(vp), trread(vp + 16 * VPITCH)), pb, o[et], 0, 0, 0);
            }
        }
    }
    float s1 = 0.f;
#pragma unroll
    for (int et = 0; et < 8; ++et) s1 += (o[et][0] + o[et][1]) + (o[et][2] + o[et][3]);
    s1 += __shfl_xor(s1, 16); s1 += __shfl_xor(s1, 32);
    const float mu = s1 * (1.f / 128.f);
    float s2 = 0.f;
#pragma unroll
    for (int et = 0; et < 8; ++et) { o[et] = o[et] - mu; s2 += (o[et][0] * o[et][0] + o[et][1] * o[et][1]) + (o[et][2] * o[et][2] + o[et][3] * o[et][3]); }
    s2 += __shfl_xor(s2, 16); s2 += __shfl_xor(s2, 32);
    const float rstd = 1.f / sqrtf(s2 * (1.f / 128.f) + GN_EPS);
    const bf16* gp = Z + (size_t)tokc * NZ + 5632 + hb * 128 + 4 * q;
    bf16* yp = Yb + (size_t)tokc * 512 + hb * 128 + 4 * q;
#pragma unroll
    for (int et = 0; et < 8; ++et) {
        const uint2 gw = *(const uint2*)(gp + et * 16);
        const float g0 = pg8::bflo(gw.x), g1 = pg8::bfhi(gw.x), g2 = pg8::bflo(gw.y), g3 = pg8::bfhi(gw.y);
        uint2 wv; wv.x = pg8::cvt_pk_bf16(o[et][0] * rstd * g0 * pg8::sigmoidf_(g0), o[et][1] * rstd * g1 * pg8::sigmoidf_(g1));
        wv.y = pg8::cvt_pk_bf16(o[et][2] * rstd * g2 * pg8::sigmoidf_(g2), o[et][3] * rstd * g3 * pg8::sigmoidf_(g3));
        *(uint2*)(yp + et * 16) = wv;
    }
}

#define RLX_AGENT __ATOMIC_RELAXED, __HIP_MEMORY_SCOPE_AGENT
#define XB_TMO      128
#define XB_XCNT(j)  (256  + 64 * (j))
#define XB_XSUB(j)  (1280 + 64 * (j))
#define XB_XGEN(j)  (2304 + 64 * (j))
#define XB_TOP      3328
#define XB_TOPGEN   3392
#define XCD_BAR_WORDS 3456
#define XB_SPIN_CAP (1u << 18)

__device__ __forceinline__ unsigned xb_ld(unsigned* p)              { return __hip_atomic_load(p, __ATOMIC_RELAXED, __HIP_MEMORY_SCOPE_AGENT); }
__device__ __forceinline__ unsigned xb_add(unsigned* p, unsigned v) { return __hip_atomic_fetch_add(p, v, __ATOMIC_RELAXED, __HIP_MEMORY_SCOPE_AGENT); }
__device__ __forceinline__ unsigned xb_xcc_id() { return (unsigned)__builtin_amdgcn_s_getreg((3 << 11) | 20) & 0xFu; }
#define XB_SPIN(cond, bar) do { unsigned _sp = 0; while (cond) { __builtin_amdgcn_s_sleep(1); \
    if ((++_sp & 255u) == 0u) { if (xb_ld(&(bar)[XB_TMO])) break; if (_sp > XB_SPIN_CAP) { atomicAdd(&(bar)[XB_TMO], 1u); break; } } } } while (0)

struct XcdBarrier {
    unsigned* bar; unsigned x;
    volatile LAS unsigned* st;
};

__device__ __forceinline__ XcdBarrier xcd_barrier_post(unsigned* bar, volatile LAS unsigned* st) {
    XcdBarrier b; b.bar = bar; b.x = xb_xcc_id(); b.st = st;
    if (threadIdx.x == 0) (void)xb_add(&bar[XB_XCNT(b.x)], 1u);
    return b;
}
__device__ __forceinline__ void xcd_barrier_complete(unsigned* bar, unsigned x, unsigned& nloc, unsigned& nx) {
    const unsigned G = gridDim.x * gridDim.y * gridDim.z;
    unsigned sum, cnt, mine, sp = 0u;
    for (;;) {
        sum = 0u; cnt = 0u; mine = 0u;
#pragma unroll
        for (unsigned j = 0; j < 16; ++j) { const unsigned c = xb_ld(&bar[XB_XCNT(j)]); sum += c; cnt += (c > 0u) ? 1u : 0u; mine = (j == x) ? c : mine; }
        if (sum == G) break;
        __builtin_amdgcn_s_sleep(1);
        if ((++sp & 255u) == 0u) { if (xb_ld(&bar[XB_TMO])) break; if (sp > XB_SPIN_CAP) { atomicAdd(&bar[XB_TMO], 1u); break; } }
    }
    nloc = mine > 0u ? mine : 1u; nx = cnt > 0u ? cnt : 1u;
}

__device__ __forceinline__ void xcd_barrier(const XcdBarrier& b) {
    asm volatile("s_waitcnt vmcnt(0)" ::: "memory");
    __syncthreads();
    if (threadIdx.x == 0) {
        unsigned* bar = b.bar;
        __builtin_amdgcn_s_waitcnt(0);
        unsigned nloc = b.st[0], nx = b.st[1];
        if (nloc == 0u) { xcd_barrier_complete(bar, b.x, nloc, nx); b.st[0] = nloc; b.st[1] = nx; }
        const unsigned old = xb_add(&bar[XB_XSUB(b.x)], 1u);
        const unsigned gen = old / nloc;
        if (old + 1u == (gen + 1u) * nloc) {
            __builtin_amdgcn_fence(__ATOMIC_RELEASE, "agent");
            asm volatile("s_waitcnt vmcnt(0)" ::: "memory");
            const unsigned og = xb_add(&bar[XB_TOP], 1u);
            const unsigned tg = og / nx;
            if (og + 1u == (tg + 1u) * nx) xb_add(&bar[XB_TOPGEN], 1u);
            else XB_SPIN(xb_ld(&bar[XB_TOPGEN]) == tg, bar);
            __builtin_amdgcn_fence(__ATOMIC_ACQUIRE, "agent");
            xb_add(&bar[XB_XGEN(b.x)], 1u);
            asm volatile("s_waitcnt vmcnt(0)" ::: "memory");
        } else {
            XB_SPIN(xb_ld(&bar[XB_XGEN(b.x)]) == gen, bar);
            __builtin_amdgcn_fence(__ATOMIC_ACQUIRE, "agent");
            asm volatile("s_waitcnt vmcnt(0)" ::: "memory");
        }
    }
    __syncthreads();
}

__device__ __forceinline__ float log_sigmoid_(float x) { return -log1pf(__expf(-x)); }
#ifndef PHMASK
#define PHMASK 0xFFFF
#endif
constexpr int NPHASE = 17;
__global__ void __launch_bounds__(NTHR, 2) fwd_megakernel(Params p) {
    extern __shared__ __attribute__((aligned(16))) unsigned char lds_raw[];
    cg::grid_group grid = cg::this_grid();
    LAS unsigned char* lds = (LAS unsigned char*)lds_raw;
    const int G = gridDim.x, bx = blockIdx.x;
    unsigned char* ws = p.ws;
    volatile LAS unsigned* bst = (volatile LAS unsigned*)(lds + 131072);
    if (threadIdx.x < 4) bst[threadIdx.x] = 0u;
    __syncthreads();
    if (ws == nullptr) grid.sync();
    const XcdBarrier xbar = xcd_barrier_post((unsigned*)ws, bst);

#pragma unroll 1
    for (int L = 0; L < DEPTH; ++L) {
        convert_weights(p, L, lds, G);
        xcd_barrier(xbar);
#pragma unroll 1
        for (int Pi = 0; Pi < 2; ++Pi) {
            const int P = (L & 1) ? 1 - Pi : Pi;
#pragma unroll 1
            for (int ph = ((L & 1) && Pi == 0) ? 1 : 0; ph < NPHASE; ++ph) {
                const int sub = ph < 3 ? ph : (ph < 15 ? 3 + (ph - 3) % 6 : ph - 6);
                const int ci = (ph >= 9 && ph < 15) ? 1 : 0;
                bf16* WB = (bf16*)(ws + WS_W); bf16* XBp = (bf16*)(ws + WS_XB); bf16* XBc = XBp + (size_t)ci * MC * D;
                bf16* Zb = (bf16*)(ws + WS_Z); bf16* Hb = (bf16*)(ws + WS_Z); bf16* MG = (bf16*)(ws + WS_Z);
                float* PART = (float*)(ws + WS_PART); bf16* GT = (bf16*)(ws + WS_G); bf16* Y = (bf16*)(ws + WS_Y); float* ST = (float*)XBc; float* LSEb = (float*)(ws + WS_LSE);
                float* EXb = (float*)(ws + WS_Y);
                unsigned* CNT = (unsigned*)(ws + WS_CNT);
                float* Xp = p.out + (size_t)P * 2 * MC * D; float* Xc = Xp + (size_t)ci * MC * D;
                const float* xinp = p.in[P];
                const int S = (P == 0) ? 8192 : 16384, nseq = MC / S;
                const bool isgemm = (sub == 1 || sub == 2 || sub == 3 || sub == 7 || sub == 8 || sub == 9 || sub == 10);
                if (isgemm) {
                    pg8::Gemm g; pg8::Sched So;
                    typedef unsigned long long u64;
                    u64 ep[10]; int mode = 0;
#pragma unroll
                    for (int i = 0; i < 10; ++i) ep[i] = 0;
                    if (sub == 1 || sub == 9) { g = pg8::Gemm{XBp, WB + (sub == 1 ? WO_W1C : WO_W2C), 2 * MC, 2 * FF, D}; So.init(2 * MC, 2 * FF, 1, G, bx, 8); mode = 0; ep[1] = (u64)Hb; }
                    else if (sub == 2) { g = pg8::Gemm{Hb, WB + WO_W1D, 2 * MC, D, FF}; So.init(2 * MC, D, 1, G, bx); mode = 1;
                        ep[1] = (u64)(L == 0 ? xinp : Xp); ep[2] = (u64)Xp; ep[3] = (u64)XBp; ep[4] = (u64)EXb; ep[5] = (u64)(p.in[5] + L * D); ep[6] = (u64)(p.in[6] + L * D); ep[7] = (u64)CNT;
                        ep[8] = (u64)__float_as_uint(ALPHA) | ((u64)__float_as_uint(0.5f) << 32); ep[9] = (u64)(unsigned)(4 * (3 * L + 1)) | ((u64)(unsigned)(P * 128) << 32); }
                    else if (sub == 10) { g = pg8::Gemm{Hb, WB + WO_W2D, 2 * MC, D, FF}; So.init(2 * MC, D, 1, G, bx); mode = 1;
                        ep[1] = (u64)Xp; ep[2] = (u64)Xp; ep[3] = (u64)XBp; ep[4] = (u64)EXb; ep[5] = (u64)(p.in[20] + L * D); ep[6] = (u64)(p.in[21] + L * D); ep[7] = (u64)CNT;
                        ep[8] = (u64)__float_as_uint(ALPHA) | ((u64)__float_as_uint(0.5f) << 32); ep[9] = (u64)(unsigned)(4 * (3 * L + 3)) | ((u64)(unsigned)(P * 128) << 32); }
                    else if (sub == 3) { g = pg8::Gemm{XBc, WB + WO_WIN, MC, DIN, D}; So.init(MC, DIN, 1, G, bx, 4); mode = 2; ep[1] = (u64)Zb; ep[2] = (u64)GT; }
                    else if (sub == 7) { g = pg8::Gemm{Y, WB + WO_PBR, 3 * MC, 3 * D, 512}; So.init(MC, D, 3, G, bx); mode = 3; ep[1] = (u64)GT; ep[2] = (u64)PART; ep[3] = (u64)MG; }
                    else { g = pg8::Gemm{MG, WB + WO_WOUT, MC, D, D}; So.init(MC, D, 1, G, bx); mode = 1;
                        ep[1] = (u64)Xc; ep[2] = (u64)Xc; ep[3] = (u64)XBc; ep[4] = (u64)EXb; ep[5] = (u64)(p.in[15] + L * D); ep[6] = (u64)(p.in[16] + L * D); ep[7] = (u64)CNT;
                        ep[8] = (u64)__float_as_uint(ALPHA) | ((u64)__float_as_uint(1.0f) << 32); ep[9] = (u64)(unsigned)(4 * (3 * L + 2)) | ((u64)(unsigned)(P * 128 + ci * 64) << 32); }
                    ep[0] = (u64)(unsigned)mode;
                    if (threadIdx.x == 0) {
                        LAS u64* epl = (LAS u64*)(lds + 131072 + 64 + 2240);
#pragma unroll
                        for (int i = 0; i < 10; ++i) epl[i] = ep[i];
                    }
                    __syncthreads();
                    if (mode == 1) pg8::gemm_phase(lds, g, So, pg8::EpiAll<1>{}); else if (mode == 3) pg8::gemm_phase(lds, g, So, pg8::EpiAll<2>{}); else pg8::gemm_phase(lds, g, So, pg8::EpiAll<0>{});
                } else {
                    int tid = threadIdx.x; asm volatile("" : "+v"(tid));
                    const int gtid = bx * NTHR + tid, gthreads = G * NTHR;
                    if (sub == 0) {
                        convert_rows(L == 0 ? xinp : Xp, XBp, 2 * MC, gtid, gthreads);
                    } else if (sub == 4) {
                        constexpr int NB1 = 128 * 4, NA = 3 * 512, NC = 64 * 8;
                        const float* rpb = p.in[10] + L * 8 * 15 * 31;
                        int it = bx;
#pragma unroll 1
                        for (; it < NB1; it += G) { int t2 = tid; asm volatile("" : "+v"(t2)); const int gn = it >> 2, hb = it & 3;
                            mixB1_mfma_unit(Zb, ST, lds, gn, hb, log_sigmoid_(p.in[8][L * 4 + hb]), log_sigmoid_(p.in[9][L * 4 + hb]), t2); }
                        if (it < NB1 + NA) {
                            pg8::u32x4 abuf[A_NIT];
                            { int t2 = tid; asm volatile("" : "+v"(t2)); mixA_load(Zb, it - NB1, S, t2, abuf); }
#pragma unroll 1
                            for (; it < NB1 + NA; it += G) {
                                int t2 = tid; asm volatile("" : "+v"(t2));
                                __syncthreads(); mixA_store(lds, t2, abuf); __syncthreads();
                                if (it + G < NB1 + NA) mixA_load(Zb, it + G - NB1, S, t2, abuf);
                                mixA_compute(Zb, LSEb, lds, it - NB1, S, t2);
                            }
                        }
#pragma unroll 1
                        for (; it < NB1 + NA + NC; it += G) { int t2 = tid; asm volatile("" : "+v"(t2)); mixC_mfma_unit(Zb, Y + (size_t)2 * MC * 512, rpb, lds, it - NB1 - NA, S, t2); }
                    } else if (sub == 5) {
                        mixB2(ST, S, nseq, p.in[8] + L * 4, p.in[9] + L * 4, gtid, gthreads);
                    } else if (sub == 6) {
#pragma unroll 1
                        for (int it = bx; it < 128 * 4; it += G) { const int gn = it >> 2, hb = it & 3; int t2 = tid; asm volatile("" : "+v"(t2));
                            mixB3_mfma_unit(Zb, ST, Y + (size_t)MC * 512, lds, gn, hb, log_sigmoid_(p.in[8][L * 4 + hb]), log_sigmoid_(p.in[9][L * 4 + hb]), t2); }
                        mixA_merge(Zb, LSEb, Y, gtid, gthreads);
                    }
                }
                xcd_barrier(xbar);
            }
        }
    }
}

extern "C" void kernel_launch(void* const* d_in, const int* in_sizes, int n_in, void* d_out, int out_size, void* d_ws, size_t ws_size, hipStream_t stream) {
    static int grid = 0;
    if (grid == 0) {
        if (n_in != 22 || out_size != NTOK * D || ws_size < WS_END) { fprintf(stderr, "kernel_launch: unexpected shapes (n_in %d out %d ws %zu)\n", n_in, out_size, ws_size); grid = -1; return; }
        int dev = 0, cus = 0, per_cu = 0;
        hipGetDevice(&dev);
        hipDeviceGetAttribute(&cus, hipDeviceAttributeMultiprocessorCount, dev);
        hipFuncSetAttribute((const void*)fwd_megakernel, hipFuncAttributeMaxDynamicSharedMemorySize, LDS_BYTES);
        hipOccupancyMaxActiveBlocksPerMultiprocessor(&per_cu, (const void*)fwd_megakernel, NTHR, LDS_BYTES);
        if (per_cu < 1) { fprintf(stderr, "kernel_launch: occupancy query gives %d\n", per_cu); per_cu = 1; }
        (void)hipGetLastError();
        grid = cus * 1;
    }
    if (grid < 0) return;
    if (hipMemsetAsync(d_ws, 0, 32768, stream) != hipSuccess) { fprintf(stderr, "kernel_launch: memset of barrier words failed\n"); return; }
    Params p{};
    for (int i = 0; i < 22; ++i) p.in[i] = (const float*)d_in[i];
    p.out = (float*)d_out; p.ws = (unsigned char*)d_ws;
    void* args[] = {&p};
    hipError_t e = hipLaunchCooperativeKernel((const void*)fwd_megakernel, dim3(grid), dim3(NTHR), args, LDS_BYTES, stream);
    if (e != hipSuccess) fprintf(stderr, "cooperative launch failed: %s (grid %d)\n", hipGetErrorString(e), grid);
}
```
